# Optimizing an MI355X kernel written in HIP

```python
import jax, jax.numpy as jnp
from jax import lax
import numpy as np

D_MODEL = 1024
BATCH = 8
SEQ = 8192
DEPTH = 2

GRID_W = 64
CTX_LEN = 256
N_MIXERS = 2
N_NA_LAYERS = (DEPTH + N_MIXERS - 1) // N_MIXERS
N_MLA_LAYERS = DEPTH // N_MIXERS
NORM_EPS = 1e-6
NEG_INF = -1e30

NA_HEADS = 16
NA_HEAD_DIM = D_MODEL // NA_HEADS
NA_KH = 8
NA_KW = 16
NA_QC = 16
NA_KC = NA_QC + NA_KW
NA_SCALE = NA_HEAD_DIM ** -0.5

MLA_HEADS = 16
MLA_NOPE_DIM = 64
MLA_ROPE_DIM = 32
MLA_V_DIM = 64
MLA_Q_LORA = 256
MLA_KV_LORA = 128
MLA_SCALE = (MLA_NOPE_DIM + MLA_ROPE_DIM) ** -0.5
ROPE_THETA = 10000.0
Q_BLOCK = 128

N_EXPERTS = 32
TOP_K = 4
D_FF = D_MODEL
SWIGLU_ALPHA = 1.702
SWIGLU_LIMIT = 7.0
MOE_BLOCK = 256

kernel_name = 'hybrid_natten_mla_moe_dit'


def rmsnorm(x, g):
    xf = x.astype(jnp.float32)
    y = xf * lax.rsqrt(jnp.mean(xf * xf, axis=-1, keepdims=True) + NORM_EPS)
    return (y * g.astype(jnp.float32)).astype(x.dtype)


def modulate(h, shift, scale):
    return h * (1 + scale) + shift


def dense_attend(q, k, v):
    s = jnp.einsum('bqhd,bkhd->bhqk', q, k).astype(jnp.float32)
    p = jax.nn.softmax(s, axis=-1).astype(v.dtype)
    return jnp.einsum('bhqk,bkhd->bqhd', p, v)


def blocked_attend(q, k, v):
    B, S, H, dq = q.shape
    nb = S // Q_BLOCK
    qb = q.reshape(B, nb, Q_BLOCK, H, dq).transpose(1, 0, 2, 3, 4)
    ob = lax.map(lambda qi: dense_attend(qi, k, v), qb)
    return ob.transpose(1, 0, 2, 3, 4).reshape(B, S, H * v.shape[-1])


def axial_rope_tables(n_tokens, dim, dtype):
    t = jnp.arange(n_tokens, dtype=jnp.int32)
    row = (t // GRID_W).astype(jnp.float32)
    col = (t % GRID_W).astype(jnp.float32)
    axis_dim = dim // 2
    inv_freq = ROPE_THETA ** (-jnp.arange(0, axis_dim, 2, dtype=jnp.float32) / axis_dim)
    ang = jnp.concatenate([row[:, None] * inv_freq, col[:, None] * inv_freq], axis=-1)
    return jnp.cos(ang).astype(dtype), jnp.sin(ang).astype(dtype)


def apply_rope(x, cos, sin):
    xp = x.reshape(x.shape[:-1] + (x.shape[-1] // 2, 2))
    x0, x1 = xp[..., 0], xp[..., 1]
    return jnp.stack([x0 * cos - x1 * sin, x0 * sin + x1 * cos], axis=-1).reshape(x.shape)


def neighbourhood_attend(q, k, v, k_ctx, v_ctx, rpb):
    B, R, W, H, hd = q.shape
    kh = min(NA_KH, R)
    n_cb = W // NA_QC
    q_cols = np.arange(W).reshape(n_cb, NA_QC)
    band_start = np.clip(np.arange(n_cb) * NA_QC - NA_KW // 2, 0, W - NA_KC)
    band_cols = band_start[:, None] + np.arange(NA_KC)[None, :]
    win_start = np.clip(q_cols - NA_KW // 2, 0, W - NA_KW)
    bc = band_cols[:, None, :]
    col_ok = (bc >= win_start[:, :, None]) & (bc < win_start[:, :, None] + NA_KW)
    col_bias_idx = np.clip(bc - q_cols[:, :, None] + NA_KW - 1, 0, 2 * NA_KW - 2)
    n_loc = kh * NA_KC

    def row_fn(r):
        ws = jnp.clip(r - kh // 2, 0, R - kh)
        qb = lax.dynamic_index_in_dim(q, r, axis=1, keepdims=False).reshape(B, n_cb, NA_QC, H, hd)
        kb = lax.dynamic_slice_in_dim(k, ws, kh, axis=1)[:, :, band_cols]
        vb = lax.dynamic_slice_in_dim(v, ws, kh, axis=1)[:, :, band_cols]
        row_idx = ws + jnp.arange(kh) - r + NA_KH - 1
        bias = rpb[:, row_idx[:, None, None, None], col_bias_idx[None]]
        bias = bias.transpose(0, 2, 3, 1, 4).astype(jnp.float32)
        s_loc = jnp.einsum('bnqhd,binjhd->bhnqij', qb, kb).astype(jnp.float32) + bias
        s_loc = jnp.where(col_ok[:, :, None, :], s_loc, NEG_INF).reshape(B, H, n_cb, NA_QC, n_loc)
        s_ctx = jnp.einsum('bnqhd,blhd->bhnql', qb, k_ctx).astype(jnp.float32)
        p = jax.nn.softmax(jnp.concatenate([s_loc, s_ctx], axis=-1), axis=-1).astype(v.dtype)
        p_loc = p[..., :n_loc].reshape(B, H, n_cb, NA_QC, kh, NA_KC)
        o = jnp.einsum('bhnqij,binjhd->bnqhd', p_loc, vb) + jnp.einsum('bhnql,blhd->bnqhd', p[..., n_loc:], v_ctx)
        return o.reshape(B, W, H * hd)

    out = lax.map(row_fn, jnp.arange(R, dtype=jnp.int32))
    return out.transpose(1, 0, 2, 3).reshape(B, R * W, H * hd)


def na_mixer(a_lat, a_ctx, w_qkv, rpb, w_o, need_ctx):
    B, S, _ = a_lat.shape
    L = a_ctx.shape[1]
    inner = NA_HEADS * NA_HEAD_DIM
    grid = (B, S // GRID_W, GRID_W, NA_HEADS, NA_HEAD_DIM)
    q, k, v = jnp.split(a_lat @ w_qkv, 3, axis=-1)
    k_ctx, v_ctx = jnp.split(a_ctx @ w_qkv[:, inner:], 2, axis=-1)
    k_ctx = k_ctx.reshape(B, L, NA_HEADS, NA_HEAD_DIM)
    v_ctx = v_ctx.reshape(B, L, NA_HEADS, NA_HEAD_DIM)
    o_lat = neighbourhood_attend(q.reshape(grid) * NA_SCALE, k.reshape(grid), v.reshape(grid), k_ctx, v_ctx, rpb) @ w_o
    if need_ctx:
        q_ctx = (a_ctx @ w_qkv[:, :inner]).reshape(B, L, NA_HEADS, NA_HEAD_DIM) * NA_SCALE
        o_ctx = dense_attend(q_ctx, k_ctx, v_ctx).reshape(B, L, inner) @ w_o
    else:
        o_ctx = None
    return o_lat, o_ctx


def mla_queries(q_lat, q_norm_g, w_qb):
    B, T, _ = q_lat.shape
    q = (rmsnorm(q_lat, q_norm_g) @ w_qb).reshape(B, T, MLA_HEADS, MLA_NOPE_DIM + MLA_ROPE_DIM)
    return q[..., :MLA_NOPE_DIM], q[..., MLA_NOPE_DIM:]


def mla_keys_values(kv_lat, k_rope, kv_norm_g, w_kvb):
    B, T, _ = kv_lat.shape
    kv = (rmsnorm(kv_lat, kv_norm_g) @ w_kvb).reshape(B, T, MLA_HEADS, MLA_NOPE_DIM + MLA_V_DIM)
    k_nope, v = kv[..., :MLA_NOPE_DIM], kv[..., MLA_NOPE_DIM:]
    k_r = jnp.broadcast_to(k_rope[:, :, None, :], (B, T, MLA_HEADS, MLA_ROPE_DIM))
    return jnp.concatenate([k_nope, k_r], axis=-1), v


def mla_mixer(a_lat, a_ctx, w_a, q_norm_g, w_qb, kv_norm_g, w_kvb, w_o, need_ctx):
    B, S, _ = a_lat.shape
    L = a_ctx.shape[1]
    split_at = [MLA_Q_LORA, MLA_Q_LORA + MLA_KV_LORA]
    cos, sin = axial_rope_tables(S, MLA_ROPE_DIM, a_lat.dtype)
    q_l, kv_l, kr_l = jnp.split(a_lat @ w_a, split_at, axis=-1)
    qn, qr = mla_queries(q_l, q_norm_g, w_qb)
    q_lat = jnp.concatenate([qn, apply_rope(qr, cos[:, None, :], sin[:, None, :])], axis=-1) * MLA_SCALE
    k_lat, v_lat = mla_keys_values(kv_l, apply_rope(kr_l, cos, sin), kv_norm_g, w_kvb)
    q_c, kv_c, kr_c = jnp.split(a_ctx @ w_a, split_at, axis=-1)
    k_ctx, v_ctx = mla_keys_values(kv_c, kr_c, kv_norm_g, w_kvb)
    k_all = jnp.concatenate([k_lat, k_ctx], axis=1)
    v_all = jnp.concatenate([v_lat, v_ctx], axis=1)
    o_lat = blocked_attend(q_lat, k_all, v_all) @ w_o
    if need_ctx:
        qn_c, qr_c = mla_queries(q_c, q_norm_g, w_qb)
        q_ctx = jnp.concatenate([qn_c, qr_c], axis=-1) * MLA_SCALE
        o_ctx = dense_attend(q_ctx, k_ctx, v_ctx).reshape(B, L, MLA_HEADS * MLA_V_DIM) @ w_o
    else:
        o_ctx = None
    return o_lat, o_ctx


def clamped_swiglu(h):
    h_glu, h_lin = h[..., ::2], h[..., 1::2]
    h_glu = jnp.minimum(h_glu, SWIGLU_LIMIT)
    h_lin = jnp.clip(h_lin, -SWIGLU_LIMIT, SWIGLU_LIMIT)
    return h_glu * jax.nn.sigmoid(SWIGLU_ALPHA * h_glu) * (h_lin + 1)


def moe(xt, w_r, b_r, w1, b1, w2, b2):
    T, D = xt.shape
    logits = (xt @ w_r + b_r).astype(jnp.float32)
    top_val, top_idx = lax.top_k(logits, TOP_K)
    gate = jax.nn.softmax(top_val, axis=-1).astype(xt.dtype)
    n_assign = T * TOP_K
    flat_e = top_idx.reshape(-1)
    order = jnp.argsort(flat_e)
    sorted_e = flat_e[order]
    counts = jnp.bincount(flat_e, length=N_EXPERTS)
    starts = jnp.cumsum(counts) - counts
    padded = (counts + MOE_BLOCK - 1) // MOE_BLOCK * MOE_BLOCK
    pad_ends = jnp.cumsum(padded)
    pad_starts = pad_ends - padded
    dest = pad_starts[sorted_e] + (jnp.arange(n_assign, dtype=jnp.int32) - starts[sorted_e])
    n_blocks = (n_assign + N_EXPERTS * (MOE_BLOCK - 1) + MOE_BLOCK - 1) // MOE_BLOCK
    n_slots = n_blocks * MOE_BLOCK
    slot_tok = jnp.full((n_slots,), T, jnp.int32).at[dest].set((order // TOP_K).astype(jnp.int32))
    slot_gate = jnp.zeros((n_slots,), xt.dtype).at[dest].set(gate.reshape(-1)[order])
    block_e = jnp.minimum(jnp.searchsorted(pad_ends, jnp.arange(n_blocks, dtype=jnp.int32) * MOE_BLOCK, side='right'), N_EXPERTS - 1)
    x_pad = jnp.concatenate([xt, jnp.zeros((1, D), xt.dtype)], axis=0)

    def block_fn(args):
        tok, e = args
        h = x_pad[tok] @ w1[e] + b1[e]
        return clamped_swiglu(h) @ w2[e] + b2[e]

    y = lax.map(block_fn, (slot_tok.reshape(n_blocks, MOE_BLOCK), block_e)).reshape(n_slots, D)
    return jax.ops.segment_sum(y * slot_gate[:, None], slot_tok, num_segments=T + 1)[:T]


def setup_inputs(seed: int = 0) -> dict:
    key = jax.random.key(seed)
    ks = jax.random.split(key, 24)
    D = D_MODEL
    na_inner = NA_HEADS * NA_HEAD_DIM

    def nrm(k, shape, scale):
        return jax.random.normal(k, shape, jnp.float32) * scale

    return {
        'x': nrm(ks[0], (BATCH, SEQ, D), 1.0),
        'c': nrm(ks[1], (BATCH, D), 1.0),
        'ctx': nrm(ks[2], (BATCH, CTX_LEN, D), 1.0),
        'c_ctx': nrm(ks[3], (D,), 1.0),
        'ada_w': nrm(ks[4], (DEPTH, D, 6 * D), D ** -0.5),
        'ada_b': nrm(ks[5], (DEPTH, 6 * D), 0.02),
        'norm_mix_g': 1.0 + nrm(ks[6], (DEPTH, D), 0.02),
        'norm_ffn_g': 1.0 + nrm(ks[7], (DEPTH, D), 0.02),
        'na_w_qkv': nrm(ks[8], (N_NA_LAYERS, D, 3 * na_inner), D ** -0.5),
        'na_rpb': nrm(ks[9], (N_NA_LAYERS, NA_HEADS, 2 * NA_KH - 1, 2 * NA_KW - 1), 0.1),
        'na_w_o': nrm(ks[10], (N_NA_LAYERS, na_inner, D), na_inner ** -0.5),
        'mla_w_a': nrm(ks[11], (N_MLA_LAYERS, D, MLA_Q_LORA + MLA_KV_LORA + MLA_ROPE_DIM), D ** -0.5),
        'mla_q_norm_g': 1.0 + nrm(ks[12], (N_MLA_LAYERS, MLA_Q_LORA), 0.02),
        'mla_w_qb': nrm(ks[13], (N_MLA_LAYERS, MLA_Q_LORA, MLA_HEADS * (MLA_NOPE_DIM + MLA_ROPE_DIM)), MLA_Q_LORA ** -0.5),
        'mla_kv_norm_g': 1.0 + nrm(ks[14], (N_MLA_LAYERS, MLA_KV_LORA), 0.02),
        'mla_w_kvb': nrm(ks[15], (N_MLA_LAYERS, MLA_KV_LORA, MLA_HEADS * (MLA_NOPE_DIM + MLA_V_DIM)), MLA_KV_LORA ** -0.5),
        'mla_w_o': nrm(ks[16], (N_MLA_LAYERS, MLA_HEADS * MLA_V_DIM, D), (MLA_HEADS * MLA_V_DIM) ** -0.5),
        'moe_w_router': nrm(ks[17], (DEPTH, D, N_EXPERTS), D ** -0.5),
        'moe_b_router': nrm(ks[18], (DEPTH, N_EXPERTS), 0.01),
        'moe_w1': nrm(ks[19], (DEPTH, N_EXPERTS, D, 2 * D_FF), D ** -0.5),
        'moe_b1': nrm(ks[20], (DEPTH, N_EXPERTS, 2 * D_FF), 0.01),
        'moe_w2': nrm(ks[21], (DEPTH, N_EXPERTS, D_FF, D), D_FF ** -0.5),
        'moe_b2': nrm(ks[22], (DEPTH, N_EXPERTS, D), 0.01),
        'final_norm_g': 1.0 + nrm(ks[23], (D,), 0.02),
    }


def reference(x, c, ctx, c_ctx, ada_w, ada_b, norm_mix_g, norm_ffn_g,
              na_w_qkv, na_rpb, na_w_o,
              mla_w_a, mla_q_norm_g, mla_w_qb, mla_kv_norm_g, mla_w_kvb, mla_w_o,
              moe_w_router, moe_b_router, moe_w1, moe_b1, moe_w2, moe_b2, final_norm_g):
    B, S, D = x.shape
    L = ctx.shape[1]
    silu_c = jax.nn.silu(c)
    silu_cc = jax.nn.silu(c_ctx)
    h_lat, h_ctx = x, ctx
    for i in range(DEPTH):
        need_ctx = i < DEPTH - 1
        j = i // N_MIXERS
        mod_lat = (silu_c @ ada_w[i] + ada_b[i])[:, None, :]
        mod_ctx = (silu_cc @ ada_w[i] + ada_b[i])[None, None, :]
        sh1, sc1, g1, sh2, sc2, g2 = jnp.split(mod_lat, 6, axis=-1)
        csh1, csc1, cg1, csh2, csc2, cg2 = jnp.split(mod_ctx, 6, axis=-1)

        a_lat = modulate(rmsnorm(h_lat, norm_mix_g[i]), sh1, sc1)
        a_ctx = modulate(rmsnorm(h_ctx, norm_mix_g[i]), csh1, csc1)
        if i % N_MIXERS == 0:
            o_lat, o_ctx = na_mixer(a_lat, a_ctx, na_w_qkv[j], na_rpb[j], na_w_o[j], need_ctx)
        else:
            o_lat, o_ctx = mla_mixer(a_lat, a_ctx, mla_w_a[j], mla_q_norm_g[j], mla_w_qb[j],
                                     mla_kv_norm_g[j], mla_w_kvb[j], mla_w_o[j], need_ctx)
        h_lat = h_lat + g1 * o_lat

        f_lat = modulate(rmsnorm(h_lat, norm_ffn_g[i]), sh2, sc2).reshape(B * S, D)
        if need_ctx:
            h_ctx = h_ctx + cg1 * o_ctx
            f_ctx = modulate(rmsnorm(h_ctx, norm_ffn_g[i]), csh2, csc2).reshape(B * L, D)
            y = moe(jnp.concatenate([f_lat, f_ctx], axis=0), moe_w_router[i], moe_b_router[i],
                    moe_w1[i], moe_b1[i], moe_w2[i], moe_b2[i])
            h_lat = h_lat + g2 * y[:B * S].reshape(B, S, D)
            h_ctx = h_ctx + cg2 * y[B * S:].reshape(B, L, D)
        else:
            y = moe(f_lat, moe_w_router[i], moe_b_router[i], moe_w1[i], moe_b1[i], moe_w2[i], moe_b2[i])
            h_lat = h_lat + g2 * y.reshape(B, S, D)
    return rmsnorm(h_lat, final_norm_g)
```

```cpp
#include <hip/hip_runtime.h>
#include <hip/hip_bf16.h>
#include <cstdio>
#include <cstdint>
#include <cmath>
__device__ __forceinline__ int opaque_tid(int wv) { int l; asm volatile("v_mbcnt_lo_u32_b32 %0, -1, 0\n\tv_mbcnt_hi_u32_b32 %0, -1, %0" : "=v"(l)); return (wv << 6) | l; }
__device__ __forceinline__ unsigned char* opaque_ws();
__device__ __forceinline__ const float* opaque_in(int i);
namespace pg8 {
#define PG8_LAS __attribute__((address_space(3)))
typedef unsigned short bf16_t;
typedef short bf16x8 __attribute__((ext_vector_type(8)));
typedef float f32x4 __attribute__((ext_vector_type(4)));
typedef unsigned u32x4 __attribute__((ext_vector_type(4)));
constexpr int BM = 256, BK = 64, HALF = 128, HTB = HALF * BK * 2  , STAGE_BYTES = 8 * HTB, NXCD = 8, WGM = 8;

__host__ __device__ __forceinline__ int lds_byte(int r, int c) { const int st = (r >> 4) * 2 + (c >> 5), rr = r & 15, cc = c & 31, ob = rr * 64 + cc * 2; return st * 1024 + (ob ^ (((ob >> 9) & 1) << 5)); }
__host__ __device__ __forceinline__ void stage_rc(int b, int& R, int& C) { const int st = b / 1024, sb = b % 1024, swz = sb ^ (((sb >> 9) & 1) << 5); R = (st >> 1) * 16 + swz / 64; C = (st & 1) * 32 + (swz % 64) / 2; }
__host__ __device__ __forceinline__ int perm32(int rho) { const int n = rho >> 4, i = rho & 15; return 8 * (i >> 2) + 4 * n + (i & 3); }

struct Unit { int pm, pn; };
struct Gemm { const bf16_t* A; const bf16_t* Bt; int M, N, K; };

template <class S, class = void> struct SchedGather { static constexpr bool v = false; };
template <class S> struct SchedGather<S, decltype((void)S::GATHER)> { static constexpr bool v = S::GATHER; };
struct StaticOrder {
    int nM, nN, nwg, G, c;
    __host__ __device__ void init(int M, int N, int G_, int c_) { nM = M / BM; nN = N / BM; nwg = nM * nN; G = G_; c = c_; }
    __host__ __device__ bool next(int i, Unit& u) const {
        const long L = (long)i * G + c; if (L >= nwg) return false;
        int wgid = (int)L; { const int q = nwg / NXCD, r = nwg % NXCD, xcd = wgid % NXCD, off = wgid / NXCD; wgid = (xcd < r ? xcd * (q + 1) : r * (q + 1) + (xcd - r) * q) + off; }
        const int nig = WGM * nN, gid = wgid / nig, fm = gid * WGM, gsz = (nM - fm) < WGM ? (nM - fm) : WGM;
        u.pm = fm + ((wgid % nig) % gsz); u.pn = (wgid % nig) / gsz; return true;
    }
    __device__ __forceinline__ void a_ready(const Unit&) const {}
    __device__ __forceinline__ void done(const Unit&) const {}
};

__device__ __forceinline__ unsigned cvt_pk_bf16(float lo, float hi) { unsigned r; asm volatile("v_cvt_pk_bf16_f32 %0, %1, %2" : "=v"(r) : "v"(lo), "v"(hi)); return r; }
template <class Epi, class Sched, bool ALIGN_EPI = false, bool SP2 = false, bool FP8 = false>
__device__ __forceinline__ void gemm_phase(PG8_LAS unsigned char* lds, const Gemm g, const Sched& S, const Epi& E, const int wv) {
    const int tid = opaque_tid(wv), wid = __builtin_amdgcn_readfirstlane(tid >> 6), lane = tid & 63, wr = wid >> 2, wc = wid & 3, fr = lane & 15, fq = lane >> 4;
    const int K = g.K, nt = K / BK;
    unsigned voffA[2], voffB[2];
#pragma unroll
    for (int i = 0; i < 2; ++i) { int R, C; stage_rc(tid * 16 + i * 8192, R, C); const int Rb = Epi::PERM ? ((R & ~31) + perm32(R & 31)) : R;
        voffA[i] = (unsigned)(R * K + C) * 2u; voffB[i] = (unsigned)(Rb * K + C) * 2u; }
    const size_t kstep = (size_t)(BK * 2);
    const size_t hstep = (size_t)HALF * K * 2;
    const size_t tstep = 2 * hstep;
    constexpr bool GATHER = SchedGather<Sched>::v;
    unsigned voffA1[2] = {voffA[0], voffA[1]};
    const size_t hstepA = GATHER ? 0 : hstep, tstepA = GATHER ? 0 : tstep;
#define PG8_GTAB(par) (lds + 131072 + (par) * 1024)
#define PG8_GFILL(unit, par) do { if (wid < 4) __builtin_amdgcn_global_load_lds((const unsigned*)(S.s2t + (size_t)(unit).pm * 256 + wid * 64 + (opaque_tid(wv) & 63)), (PG8_LAS unsigned*)(PG8_GTAB(par) + wid * 256), 4, 0, 0); } while (0)
#define PG8_GLOAD(par) do { const int t2_ = opaque_tid(wv); _Pragma("unroll") for (int i_ = 0; i_ < 2; ++i_) { int R_, C_; stage_rc(t2_ * 16 + i_ * 8192, R_, C_); const PG8_LAS int* rt_ = (const PG8_LAS int*)PG8_GTAB(par); \
        voffA[i_] = (unsigned)(rt_[R_] * K + C_) * 2u; voffA1[i_] = (unsigned)(rt_[R_ + 128] * K + C_) * 2u; } } while (0)
    const unsigned ldsw = (unsigned)wid * 1024u;
    const int aoff = lds_byte(wr * 64 + fr, fq * 8), boff = lds_byte(wc * 32 + fr, fq * 8);
    typedef int v4i_ __attribute__((ext_vector_type(4)));
#define PG8_SA(b, h) (((b) * 2 + (h)) * HTB)
#define PG8_SB(b, h) ((4 + (b) * 2 + (h)) * HTB)
#define PG8_STAGE(bufoff, gbase, voff) do { if constexpr (FP8) { unsigned keep_; \
        asm volatile("s_mov_b32 %0, m0\n\ts_mov_b32 m0, %4\n\ts_nop 0\n\tglobal_load_lds_dwordx4 %1, %3\n\ts_add_u32 m0, m0, 0x2000\n\ts_nop 0\n\tglobal_load_lds_dwordx4 %2, %3\n\ts_mov_b32 m0, %0" \
                     : "=&s"(keep_) : "v"((voff)[0]), "v"((voff)[1]), "s"((const char*)(gbase)), "s"((unsigned)(size_t)(lds + (bufoff) + ldsw)) : "memory"); } else { _Pragma("unroll") for (int _i = 0; _i < 2; ++_i) \
        __builtin_amdgcn_global_load_lds((const unsigned*)((const char*)(gbase) + (voff)[_i]), (PG8_LAS unsigned*)(lds + (bufoff) + ldsw + _i * 8192), 16, 0, 0); } } while (0)
#define PG8_CAT8(x, y) __builtin_shufflevector(__builtin_bit_cast(v4i_, x), __builtin_bit_cast(v4i_, y), 0, 1, 2, 3, 4, 5, 6, 7)
#define PG8_LDA(dst, b, h) do { if constexpr (FP8) { _Pragma("unroll") for (int m = 0; m < 4; ++m) dst##8[m] = PG8_CAT8(*(const PG8_LAS bf16x8*)(lds + PG8_SA(b, h) + aoff + m * 2048), *(const PG8_LAS bf16x8*)(lds + PG8_SA(b, h) + aoff + m * 2048 + 1024)); } else { \
        _Pragma("unroll") for (int m = 0; m < 4; ++m) _Pragma("unroll") for (int k = 0; k < 2; ++k) dst[m][k] = *(const PG8_LAS bf16x8*)(lds + PG8_SA(b, h) + aoff + m * 2048 + k * 1024); } } while (0)
#define PG8_LDB(dst, b, h) do { if constexpr (FP8) { _Pragma("unroll") for (int n = 0; n < 2; ++n) dst##8[n] = PG8_CAT8(*(const PG8_LAS bf16x8*)(lds + PG8_SB(b, h) + boff + n * 2048), *(const PG8_LAS bf16x8*)(lds + PG8_SB(b, h) + boff + n * 2048 + 1024)); } else { \
        _Pragma("unroll") for (int n = 0; n < 2; ++n) _Pragma("unroll") for (int k = 0; k < 2; ++k) dst[n][k] = *(const PG8_LAS bf16x8*)(lds + PG8_SB(b, h) + boff + n * 2048 + k * 1024); } } while (0)
#define PG8_MMA(ai, bj, At, Bt) do { __builtin_amdgcn_s_setprio(1); if constexpr (FP8) { _Pragma("unroll") for (int m = 0; m < 4; ++m) _Pragma("unroll") for (int n = 0; n < 2; ++n) \
        acc[ai][bj][m][n] = __builtin_amdgcn_mfma_scale_f32_16x16x128_f8f6f4(Bt##8[n], At##8[m], acc[ai][bj][m][n], 0, 0, 0, 0x7f7f7f7f, 0, 0x7f7f7f7f); } else { \
        _Pragma("unroll") for (int m = 0; m < 4; ++m) _Pragma("unroll") for (int n = 0; n < 2; ++n) _Pragma("unroll") for (int k = 0; k < 2; ++k) \
        acc[ai][bj][m][n] = __builtin_amdgcn_mfma_f32_16x16x32_bf16(Bt[n][k], At[m][k], acc[ai][bj][m][n], 0, 0, 0); } __builtin_amdgcn_s_setprio(0); } while (0)
#define PG8_WAIT_V(n) asm volatile("s_waitcnt vmcnt(" #n ")" ::: "memory")
#define PG8_WAIT_L(n) asm volatile("s_waitcnt lgkmcnt(" #n ")" ::: "memory")
#define PG8_BAR __builtin_amdgcn_s_barrier()
#define PG8_SCHED __builtin_amdgcn_sched_barrier(0)
    Unit cur, nxt; int ui = 0;
    if (!S.next(0, cur)) return;
    f32x4 acc[2][2][4][2];
#pragma unroll
    for (int a = 0; a < 2; ++a)
#pragma unroll
        for (int b = 0; b < 2; ++b)
#pragma unroll
            for (int m = 0; m < 4; ++m)
#pragma unroll
                for (int n = 0; n < 2; ++n) acc[a][b][m][n] = (f32x4){0.f, 0.f, 0.f, 0.f};
    bf16x8 At[4][2], B0[2][2], B1[2][2]; typedef int v8i_ __attribute__((ext_vector_type(8))); v8i_ At8[4], B08[2], B18[2];
    const char* cA = (const char*)g.A + (size_t)cur.pm * tstepA; const char* cB = (const char*)g.Bt + (size_t)cur.pn * tstep;
    S.a_ready(cur);
    if constexpr (GATHER) { PG8_GFILL(cur, 0); PG8_WAIT_V(0); PG8_BAR; PG8_GLOAD(0); }
    if constexpr (SP2) {
        PG8_STAGE(PG8_SB(0, 0), cB, voffB); PG8_STAGE(PG8_SB(0, 1), cB + hstep, voffB); PG8_STAGE(PG8_SA(0, 0), cA, voffA); PG8_STAGE(PG8_SA(0, 1), cA + hstepA, voffA1);
        if (wr == 1) PG8_BAR;
        PG8_WAIT_V(2); PG8_BAR;
        PG8_STAGE(PG8_SB(1, 0), cB + kstep, voffB); PG8_STAGE(PG8_SA(1, 0), cA + kstep, voffA); PG8_STAGE(PG8_SB(1, 1), cB + hstep + kstep, voffB);
        PG8_WAIT_V(6); PG8_BAR;
    } else {
        PG8_STAGE(PG8_SB(0, 0), cB, voffB); PG8_STAGE(PG8_SA(0, 0), cA, voffA); PG8_STAGE(PG8_SB(0, 1), cB + hstep, voffB); PG8_STAGE(PG8_SA(0, 1), cA + hstepA, voffA1);
        if (wr == 1) PG8_BAR;
        PG8_WAIT_V(4); PG8_BAR;
        PG8_STAGE(PG8_SB(1, 0), cB + kstep, voffB); PG8_STAGE(PG8_SA(1, 0), cA + kstep, voffA); PG8_STAGE(PG8_SB(1, 1), cB + hstep + kstep, voffB);
        PG8_WAIT_V(6); PG8_BAR;
    }
    for (;;) {
        const bool has_next = S.next(ui + 1, nxt);
        if constexpr (GATHER) { if (has_next) PG8_GFILL(nxt, (ui + 1) & 1); }
        const char* nA = has_next ? (const char*)g.A + (size_t)nxt.pm * tstepA : cA; const char* nB = has_next ? (const char*)g.Bt + (size_t)nxt.pn * tstep : cB;
#pragma unroll 1
        for (int t = 0; t < nt; t += 2) {
            const bool last = (t == nt - 2);
            const char* a1 = cA + (size_t)(t + 1) * kstep;
            const char* a2 = last ? nA : cA + (size_t)(t + 2) * kstep; const char* b2 = last ? nB : cB + (size_t)(t + 2) * kstep;
            const char* a3 = a2 + kstep; const char* b3 = b2 + kstep;
            if (last && has_next) S.a_ready(nxt);
            if constexpr (SP2) {
            PG8_LDB(B0, 0, 0); PG8_LDB(B1, 0, 1); PG8_SCHED; PG8_LDA(At, 0, 0); PG8_STAGE(PG8_SA(1, 1), a1 + hstepA, voffA1);
            if constexpr (GATHER) { if (last && has_next) PG8_GLOAD((ui + 1) & 1); }
            PG8_WAIT_V(8); PG8_WAIT_L(0); PG8_BAR; PG8_MMA(0, 0, At, B0); PG8_MMA(0, 1, At, B1); PG8_BAR; PG8_SCHED;
            PG8_LDA(At, 0, 1); PG8_STAGE(PG8_SB(0, 0), b2, voffB); PG8_STAGE(PG8_SB(0, 1), b2 + hstep, voffB); PG8_STAGE(PG8_SA(0, 0), a2, voffA);
            PG8_WAIT_V(8); PG8_WAIT_L(0); PG8_BAR; PG8_MMA(1, 0, At, B0); PG8_MMA(1, 1, At, B1); PG8_BAR; PG8_SCHED;
            PG8_LDB(B0, 1, 0); PG8_LDB(B1, 1, 1); PG8_SCHED; PG8_LDA(At, 1, 0); PG8_STAGE(PG8_SA(0, 1), a2 + hstepA, voffA1);
            PG8_WAIT_V(8); PG8_WAIT_L(0); PG8_BAR; PG8_MMA(0, 0, At, B0); PG8_MMA(0, 1, At, B1); PG8_BAR; PG8_SCHED;
            PG8_LDA(At, 1, 1); PG8_STAGE(PG8_SB(1, 0), b3, voffB); PG8_STAGE(PG8_SB(1, 1), b3 + hstep, voffB); PG8_STAGE(PG8_SA(1, 0), a3, voffA);
            PG8_WAIT_V(8); PG8_WAIT_L(0); PG8_BAR; PG8_MMA(1, 0, At, B0); PG8_MMA(1, 1, At, B1); PG8_BAR; PG8_SCHED;
            } else {
            PG8_LDB(B0, 0, 0); PG8_SCHED; PG8_LDA(At, 0, 0); PG8_STAGE(PG8_SA(1, 1), a1 + hstepA, voffA1);
            if constexpr (GATHER) { if (last && has_next) PG8_GLOAD((ui + 1) & 1); }
            PG8_WAIT_L(8); PG8_BAR; PG8_WAIT_L(0); PG8_MMA(0, 0, At, B0); PG8_BAR; PG8_SCHED;
            PG8_LDB(B1, 0, 1); PG8_STAGE(PG8_SB(0, 0), b2, voffB);
            PG8_BAR; PG8_WAIT_L(0); PG8_MMA(0, 1, At, B1); PG8_BAR;
            PG8_LDA(At, 0, 1); PG8_STAGE(PG8_SA(0, 0), a2, voffA);
            PG8_BAR; PG8_WAIT_L(0); PG8_MMA(1, 0, At, B0); PG8_BAR; PG8_SCHED;
            PG8_STAGE(PG8_SB(0, 1), b2 + hstep, voffB);
            PG8_WAIT_V(6); PG8_BAR; PG8_MMA(1, 1, At, B1); PG8_BAR;
            PG8_LDB(B0, 1, 0); PG8_SCHED; PG8_LDA(At, 1, 0); PG8_STAGE(PG8_SA(0, 1), a2 + hstepA, voffA1);
            PG8_WAIT_L(8); PG8_BAR; PG8_WAIT_L(0); PG8_MMA(0, 0, At, B0); PG8_BAR; PG8_SCHED;
            PG8_LDB(B1, 1, 1); PG8_STAGE(PG8_SB(1, 0), b3, voffB);
            PG8_BAR; PG8_WAIT_L(0); PG8_MMA(0, 1, At, B1); PG8_BAR;
            PG8_LDA(At, 1, 1); PG8_STAGE(PG8_SA(1, 0), a3, voffA);
            PG8_BAR; PG8_WAIT_L(0); PG8_MMA(1, 0, At, B0); PG8_BAR; PG8_SCHED;
            PG8_STAGE(PG8_SB(1, 1), b3 + hstep, voffB);
            PG8_WAIT_V(6); PG8_BAR; PG8_MMA(1, 1, At, B1); PG8_BAR;
            }
        }
        if constexpr (ALIGN_EPI) { if (wr == 0) PG8_BAR; }
        if constexpr (!Epi::AFTER_DRAIN) { E(acc, cur, wr, wc, fr, fq); S.done(cur); }
        if (!has_next) break;
#pragma unroll
        for (int a = 0; a < 2; ++a)
#pragma unroll
            for (int b = 0; b < 2; ++b)
#pragma unroll
                for (int m = 0; m < 4; ++m)
#pragma unroll
                    for (int n = 0; n < 2; ++n) acc[a][b][m][n] = (f32x4){0.f, 0.f, 0.f, 0.f};
        cur = nxt; cA = nA; cB = nB; ++ui;
        if constexpr (ALIGN_EPI) { if (wr == 1) PG8_BAR; }
    }
    PG8_WAIT_V(0);
    if constexpr (!ALIGN_EPI) { if (wr == 0) PG8_BAR; }
    PG8_BAR;
    if constexpr (Epi::AFTER_DRAIN) { E.fused(acc, cur, wr, wc, fr, fq, lds, wid, lane); S.done(cur); }
#undef PG8_GTAB
#undef PG8_GFILL
#undef PG8_GLOAD
#undef PG8_SA
#undef PG8_SB
#undef PG8_STAGE
#undef PG8_LDA
#undef PG8_LDB
#undef PG8_MMA
#undef PG8_CAT8
#undef PG8_WAIT_V
#undef PG8_WAIT_L
#undef PG8_BAR
#undef PG8_SCHED
}
}
namespace pg8 {
typedef unsigned u32x2 __attribute__((ext_vector_type(2)));
struct RowPanelOrder {
    int nM, G, c;
    __device__ __forceinline__ bool next(int i, Unit& u) const { const int L = i * G + c; if (L >= nM) return false; u.pm = L; u.pn = 0; return true; }
    __device__ __forceinline__ void a_ready(const Unit&) const {}
    __device__ __forceinline__ void done(const Unit&) const {}
};
struct MoeOrder {
    const PG8_LAS int* blk_start; int NT, G, c;
    __device__ __forceinline__ bool next(int i, Unit& u) const {
        unsigned bs_; asm volatile("v_mov_b32 %0, %1" : "=v"(bs_) : "s"((unsigned)(size_t)this->blk_start)); const PG8_LAS int* blk_start = (const PG8_LAS int*)(size_t)bs_;
        const int nblk = __builtin_amdgcn_readfirstlane(blk_start[32]);
        int rb, pn;
        if (G == 256) { const int x = c & 7, j = c >> 3, per = 32 / NT; rb = (i * per + j / NT) * 8 + x; pn = j % NT; if (rb >= nblk) return false; }
        else { const long L = (long)i * G + c; if (L >= (long)nblk * NT) return false; rb = (int)(L / NT); pn = (int)(L % NT); }
        int e = 0;
#pragma unroll
        for (int j = 1; j < 32; ++j) e += (blk_start[j] <= rb) ? 1 : 0;
        u.pm = __builtin_amdgcn_readfirstlane(rb); u.pn = __builtin_amdgcn_readfirstlane(e * NT + pn); return true;
    }
    __device__ __forceinline__ void a_ready(const Unit&) const {}
    __device__ __forceinline__ void done(const Unit&) const {}
};
struct MoeOrderG {
    static constexpr bool GATHER = true;
    const PG8_LAS int* blk_start; int NT, G, c; const int* s2t;
    __device__ __forceinline__ bool next(int i, Unit& u) const {
        unsigned bs_; asm volatile("v_mov_b32 %0, %1" : "=v"(bs_) : "s"((unsigned)(size_t)this->blk_start)); const PG8_LAS int* blk_start = (const PG8_LAS int*)(size_t)bs_;
        const int nblk = __builtin_amdgcn_readfirstlane(blk_start[32]);
        int rb, pn;
        if (G == 256) { const int x = c & 7, j = c >> 3, per = 32 / NT; rb = (i * per + j / NT) * 8 + x; pn = j % NT; if (rb >= nblk) return false; }
        else { const long L = (long)i * G + c; if (L >= (long)nblk * NT) return false; rb = (int)(L / NT); pn = (int)(L % NT); }
        int e = 0;
#pragma unroll
        for (int j = 1; j < 32; ++j) e += (blk_start[j] <= rb) ? 1 : 0;
        u.pm = __builtin_amdgcn_readfirstlane(rb); u.pn = __builtin_amdgcn_readfirstlane(e * NT + pn); return true;
    }
    __device__ __forceinline__ void a_ready(const Unit&) const {}
    __device__ __forceinline__ void done(const Unit&) const {}
};

struct EpiQKV {
    static constexpr bool PERM = true, AFTER_DRAIN = false;
    bf16_t* O; size_t split_stride; float scale0, scale1;
    __device__ __forceinline__ void operator()(const f32x4 (&acc)[2][2][4][2], const Unit& u, int wr, int wc, int fr, int fq) const {
        const int row0 = u.pm * BM + wr * 64 + fr; int colt = u.pn * BM; const int t = colt >> 10; colt &= 1023;
        bf16_t* base = O + (size_t)t * split_stride; const float sc = (t == 0) ? scale0 : scale1;
        const int col0 = colt + wc * 32 + 8 * fq;
#pragma unroll
        for (int ai = 0; ai < 2; ++ai)
#pragma unroll
            for (int m = 0; m < 4; ++m) { bf16_t* rowp = base + (size_t)(row0 + ai * HALF + m * 16) * 1024 + col0;
#pragma unroll
                for (int bj = 0; bj < 2; ++bj) { const f32x4 v0 = acc[ai][bj][m][0] * sc, v1 = acc[ai][bj][m][1] * sc;
                    u32x4 w; w.x = cvt_pk_bf16(v0[0], v0[1]); w.y = cvt_pk_bf16(v0[2], v0[3]); w.z = cvt_pk_bf16(v1[0], v1[1]); w.w = cvt_pk_bf16(v1[2], v1[3]);
                    *(u32x4*)(rowp + bj * HALF) = w; } }
    }
};
struct EpiGateRes {
    static constexpr bool PERM = false, AFTER_DRAIN = false;
    const float* resA; const float* resB; int splitRow; float* out; const float* gate; float ascale; int wv;
    __device__ __forceinline__ void operator()(const f32x4 (&acc)[2][2][4][2], const Unit& u, int, int, int, int) const {
        asm volatile("" ::: "memory");
        const int t_ = opaque_tid(wv), wid_ = t_ >> 6, wr = wid_ >> 2, wc = wid_ & 3, fr = t_ & 15, fq = (t_ & 63) >> 4;
        const int rbase = u.pm * BM; const float* res = rbase < splitRow ? resA + (size_t)rbase * 1024 : resB + (size_t)(rbase - splitRow) * 1024;
        const int bb = rbase < 65536 ? (rbase >> 13) : 8;
        const auto rs_r = __builtin_amdgcn_make_buffer_rsrc((void*)(res + u.pn * BM), 0, 0x7fffffff, 0x00020000); const auto rs_o = __builtin_amdgcn_make_buffer_rsrc((void*)(out + (size_t)rbase * 1024 + u.pn * BM), 0, 0x7fffffff, 0x00020000);
        const auto rs_g = __builtin_amdgcn_make_buffer_rsrc((void*)(gate + bb * 6144 + u.pn * BM), 0, 0x7fffffff, 0x00020000);
        const unsigned lcol = (unsigned)(wc * 32 + 4 * fq), lrow = (unsigned)(wr * 64 + fr);
#pragma unroll
        for (int bj = 0; bj < 2; ++bj)
#pragma unroll
            for (int n = 0; n < 2; ++n) { const unsigned co = (lcol + (unsigned)(bj * HALF + n * 16)) * 4u;
                const f32x4 gv = __builtin_bit_cast(f32x4, __builtin_amdgcn_raw_buffer_load_b128(rs_g, co, 0, 0)) * ascale;
#pragma unroll
                for (int ai = 0; ai < 2; ++ai)
#pragma unroll
                    for (int m = 0; m < 4; ++m) { const unsigned off = (lrow + (unsigned)(ai * HALF + m * 16)) * 4096u + co;
                        const f32x4 o = __builtin_bit_cast(f32x4, __builtin_amdgcn_raw_buffer_load_b128(rs_r, off, 0, 0)) + gv * acc[ai][bj][m][n];
                        __builtin_amdgcn_raw_buffer_store_b128(__builtin_bit_cast(u32x4, o), rs_o, off, 0, 0); } }
    }
};
struct EpiF32 {
    static constexpr bool PERM = false, AFTER_DRAIN = false;
    float* O; int ldc; float scale;
    __device__ __forceinline__ void operator()(const f32x4 (&acc)[2][2][4][2], const Unit& u, int wr, int wc, int fr, int fq) const {
        const int row0 = u.pm * BM + wr * 64 + fr, col0 = u.pn * BM + wc * 32 + 4 * fq;
#pragma unroll
        for (int ai = 0; ai < 2; ++ai)
#pragma unroll
            for (int m = 0; m < 4; ++m) { float* op = O + (size_t)(row0 + ai * HALF + m * 16) * ldc + col0;
#pragma unroll
                for (int bj = 0; bj < 2; ++bj)
#pragma unroll
                    for (int n = 0; n < 2; ++n) *(f32x4*)(op + bj * HALF + n * 16) = acc[ai][bj][m][n] * scale; }
    }
};
struct EpiRouter {
    static constexpr bool PERM = false, AFTER_DRAIN = false;
    const float* bias; int* tk_e; float* tk_g;
    __device__ __forceinline__ void operator()(const f32x4 (&acc)[2][2][4][2], const Unit& u, int wr, int wc, int fr, int fq) const {
        if (wc != 0) return;
        float bv[8];
#pragma unroll
        for (int i = 0; i < 8; ++i) bv[i] = bias[(i < 4 ? 4 * fq + i : 16 + 4 * fq + (i - 4))];
#pragma unroll
        for (int ai = 0; ai < 2; ++ai)
#pragma unroll
            for (int m = 0; m < 4; ++m) {
                const int row = u.pm * BM + ai * HALF + wr * 64 + m * 16 + fr;
                float v[8];
#pragma unroll
                for (int i = 0; i < 4; ++i) { v[i] = acc[ai][0][m][0][i] + bv[i]; v[4 + i] = acc[ai][0][m][1][i] + bv[4 + i]; }
                float tv[4]; int ti[4];
#pragma unroll
                for (int k = 0; k < 4; ++k) {
                    float b = v[0]; int bi = 4 * fq;
#pragma unroll
                    for (int i = 1; i < 8; ++i) { const int id = (i < 4 ? 4 * fq + i : 16 + 4 * fq + (i - 4)); if (v[i] > b) { b = v[i]; bi = id; } }
#pragma unroll
                    for (int off = 16; off <= 32; off <<= 1) { const float ov = __shfl_xor(b, off); const int oi = __shfl_xor(bi, off); if (ov > b || (ov == b && oi < bi)) { b = ov; bi = oi; } }
                    tv[k] = b; ti[k] = bi;
#pragma unroll
                    for (int i = 0; i < 8; ++i) { const int id = (i < 4 ? 4 * fq + i : 16 + 4 * fq + (i - 4)); if (id == bi) v[i] = -INFINITY; }
                }
                const float e1 = __expf(tv[1] - tv[0]), e2 = __expf(tv[2] - tv[0]), e3 = __expf(tv[3] - tv[0]); const float inv = 1.f / (1.f + e1 + e2 + e3);
                if (fq == 0) { *(int4*)(tk_e + (size_t)row * 4) = make_int4(ti[0], ti[1], ti[2], ti[3]); *(f32x4*)(tk_g + (size_t)row * 4) = (f32x4){inv, e1 * inv, e2 * inv, e3 * inv}; }
            }
    }
};
typedef float f32x2e __attribute__((ext_vector_type(2)));
__device__ __forceinline__ f32x2e swiglu2(f32x2e hg, f32x2e hl1) {
    f32x2e g; g.x = fminf(hg.x, 7.0f); g.y = fminf(hg.y, 7.0f);
    const f32x2e t = g * (-1.702f * 1.4426950408889634f);
    f32x2e d; d.x = __builtin_amdgcn_exp2f(t.x); d.y = __builtin_amdgcn_exp2f(t.y); d = d + 1.0f;
    f32x2e r; r.x = __builtin_amdgcn_rcpf(d.x); r.y = __builtin_amdgcn_rcpf(d.y);
    f32x2e l; l.x = __builtin_amdgcn_fmed3f(hl1.x, -6.0f, 8.0f); l.y = __builtin_amdgcn_fmed3f(hl1.y, -6.0f, 8.0f);
    return (g * r) * l;
}
struct EpiSwiglu {
    static constexpr bool PERM = true, AFTER_DRAIN = false;
    size_t act_off; int b1_in; size_t b1_off; int wv;
    __device__ __forceinline__ void operator()(const f32x4 (&acc)[2][2][4][2], const Unit& u, int, int, int, int) const {
        asm volatile("" ::: "memory");
        const int t_ = opaque_tid(wv), wid_ = t_ >> 6, wr = wid_ >> 2, wc = wid_ & 3, fr = t_ & 15, fq = (t_ & 63) >> 4;
        const int e = u.pn >> 3, pn = u.pn & 7;
        const char* actb = (const char*)(opaque_ws() + act_off) + (size_t)u.pm * (BM * 1024) + pn * 128; const char* bp = (const char*)(opaque_in(b1_in) + b1_off + (size_t)e * 2048 + pn * BM);
        const auto rs_b = __builtin_amdgcn_make_buffer_rsrc((void*)bp, 0, 0x7fffffff, 0x00020000); const auto rs_o = __builtin_amdgcn_make_buffer_rsrc((void*)actb, 0, 0x7fffffff, 0x00020000);
        const unsigned lcol = (unsigned)(wc * 32 + 8 * fq), lrow = (unsigned)(wr * 64 + fr);
        f32x4 bv[2][2];
#pragma unroll
        for (int bj = 0; bj < 2; ++bj)
#pragma unroll
            for (int n = 0; n < 2; ++n) bv[bj][n] = __builtin_bit_cast(f32x4, __builtin_amdgcn_raw_buffer_load_b128(rs_b, (lcol + (unsigned)(bj * HALF + 4 * n)) * 4u, 0, 0)) + (f32x4){0.f, 1.f, 0.f, 1.f};
#pragma unroll
        for (int ai = 0; ai < 2; ++ai)
#pragma unroll
            for (int m = 0; m < 4; ++m) { const unsigned ro = (lrow + (unsigned)(ai * HALF + m * 16)) * 1024u + (lcol >> 1);
#pragma unroll
                for (int bj = 0; bj < 2; ++bj) { const f32x4 h0 = acc[ai][bj][m][0] * (1.0f / 32.0f) + bv[bj][0], h1 = acc[ai][bj][m][1] * (1.0f / 32.0f) + bv[bj][1];
                    const f32x2e a0 = swiglu2((f32x2e){h0[0], h0[2]}, (f32x2e){h0[1], h0[3]}), a1 = swiglu2((f32x2e){h1[0], h1[2]}, (f32x2e){h1[1], h1[3]});
                    int w = __builtin_amdgcn_cvt_pk_fp8_f32(a0.x, a0.y, 0, false); w = __builtin_amdgcn_cvt_pk_fp8_f32(a1.x, a1.y, w, true);
                    __builtin_amdgcn_raw_buffer_store_b32((unsigned)w, rs_o, ro + (unsigned)(bj * (HALF / 2)), 0, 0); } }
    }
};
struct EpiExpertOut {
    static constexpr bool PERM = true, AFTER_DRAIN = false;
    size_t o_off; int b2_in; size_t b2_off; int wv;
    __device__ __forceinline__ void operator()(const f32x4 (&acc)[2][2][4][2], const Unit& u, int, int, int, int) const {
        asm volatile("" ::: "memory");
        const int t_ = opaque_tid(wv), wid_ = t_ >> 6, wr = wid_ >> 2, wc = wid_ & 3, fr = t_ & 15, fq = (t_ & 63) >> 4;
        const int e = u.pn >> 2, pn = u.pn & 3;
        const char* ob = (const char*)(opaque_ws() + o_off) + (size_t)u.pm * (BM * 1024) + pn * BM; const char* bp = (const char*)(opaque_in(b2_in) + b2_off + (size_t)e * 1024 + pn * BM);
        const auto rs_b = __builtin_amdgcn_make_buffer_rsrc((void*)bp, 0, 0x7fffffff, 0x00020000); const auto rs_o = __builtin_amdgcn_make_buffer_rsrc((void*)ob, 0, 0x7fffffff, 0x00020000);
        const unsigned lcol = (unsigned)(wc * 32 + 8 * fq), lrow = (unsigned)(wr * 64 + fr);
        f32x4 bv[2][2];
#pragma unroll
        for (int bj = 0; bj < 2; ++bj)
#pragma unroll
            for (int n = 0; n < 2; ++n) bv[bj][n] = __builtin_bit_cast(f32x4, __builtin_amdgcn_raw_buffer_load_b128(rs_b, (lcol + (unsigned)(bj * HALF + 4 * n)) * 4u, 0, 0));
#pragma unroll
        for (int ai = 0; ai < 2; ++ai)
#pragma unroll
            for (int m = 0; m < 4; ++m) { const unsigned ro = (lrow + (unsigned)(ai * HALF + m * 16)) * 1024u + lcol;
#pragma unroll
                for (int bj = 0; bj < 2; ++bj) { const f32x4 v0 = acc[ai][bj][m][0] * (1.0f / 32.0f) + bv[bj][0], v1 = acc[ai][bj][m][1] * (1.0f / 32.0f) + bv[bj][1];
                    int w0 = __builtin_amdgcn_cvt_pk_fp8_f32(v0[0], v0[1], 0, false); w0 = __builtin_amdgcn_cvt_pk_fp8_f32(v0[2], v0[3], w0, true);
                    int w1 = __builtin_amdgcn_cvt_pk_fp8_f32(v1[0], v1[1], 0, false); w1 = __builtin_amdgcn_cvt_pk_fp8_f32(v1[2], v1[3], w1, true);
                    __builtin_amdgcn_raw_buffer_store_b64((u32x2){(unsigned)w0, (unsigned)w1}, rs_o, ro + (unsigned)(bj * HALF), 0, 0); } }
    }
};
struct EpiScaleBf16 {
    static constexpr bool PERM = true, AFTER_DRAIN = false;
    bf16_t* O; int ldc; float scale;
    __device__ __forceinline__ void operator()(const f32x4 (&acc)[2][2][4][2], const Unit& u, int wr, int wc, int fr, int fq) const {
        const int row0 = u.pm * BM + wr * 64 + fr, col0 = u.pn * BM + wc * 32 + 8 * fq;
#pragma unroll
        for (int ai = 0; ai < 2; ++ai)
#pragma unroll
            for (int m = 0; m < 4; ++m) { bf16_t* rowp = O + (size_t)(row0 + ai * HALF + m * 16) * ldc + col0;
#pragma unroll
                for (int bj = 0; bj < 2; ++bj) { const f32x4 v0 = acc[ai][bj][m][0] * scale, v1 = acc[ai][bj][m][1] * scale;
                    u32x4 w; w.x = cvt_pk_bf16(v0[0], v0[1]); w.y = cvt_pk_bf16(v0[2], v0[3]); w.z = cvt_pk_bf16(v1[0], v1[1]); w.w = cvt_pk_bf16(v1[2], v1[3]);
                    *(u32x4*)(rowp + bj * HALF) = w; } }
    }
};
struct EpiKV {
    static constexpr bool PERM = true, AFTER_DRAIN = false;
    unsigned char* KN; unsigned char* VT; int wv;
    __device__ __forceinline__ void operator()(const f32x4 (&acc)[2][2][4][2], const Unit& u, int, int, int, int) const {
        asm volatile("" ::: "memory");
        const int t_ = opaque_tid(wv), wid_ = t_ >> 6, wr = wid_ >> 2, wc = wid_ & 3, fr = t_ & 15, fq = (t_ & 63) >> 4;
        const unsigned lrow = (unsigned)(wr * 64 + fr); const int j0 = wc * 32 + 8 * fq;
        if (wc < 2) {
            const auto rs = __builtin_amdgcn_make_buffer_rsrc((void*)(KN + (size_t)u.pm * (BM * 1024) + 2 * u.pn * 64), 0, 0x7fffffff, 0x00020000);
#pragma unroll
            for (int ai = 0; ai < 2; ++ai)
#pragma unroll
                for (int m = 0; m < 4; ++m) { const unsigned ro = (lrow + (unsigned)(ai * HALF + m * 16)) * 1024u + (unsigned)j0;
#pragma unroll
                    for (int bj = 0; bj < 2; ++bj) { const f32x4 v0 = acc[ai][bj][m][0], v1 = acc[ai][bj][m][1];
                        int w0 = __builtin_amdgcn_cvt_pk_fp8_f32(v0[0], v0[1], 0, false); w0 = __builtin_amdgcn_cvt_pk_fp8_f32(v0[2], v0[3], w0, true);
                        int w1 = __builtin_amdgcn_cvt_pk_fp8_f32(v1[0], v1[1], 0, false); w1 = __builtin_amdgcn_cvt_pk_fp8_f32(v1[2], v1[3], w1, true);
                        __builtin_amdgcn_raw_buffer_store_b64((u32x2){(unsigned)w0, (unsigned)w1}, rs, ro + (unsigned)(bj * 64), 0, 0); } }
        } else {
            const int rb = u.pm * BM; const int bb = rb < 65536 ? (rb >> 13) : ((rb - 65536) >> 8), tile0 = rb < 65536 ? ((rb & 8191) >> 6) : 128;
            const auto rs = __builtin_amdgcn_make_buffer_rsrc((void*)(VT + ((size_t)((bb * 16 + 2 * u.pn) * 132 + tile0)) * 4096), 0, 0x7fffffff, 0x00020000);
            const unsigned d0 = (unsigned)(j0 - 64);
#pragma unroll
            for (int ai = 0; ai < 2; ++ai)
#pragma unroll
                for (int m = 0; m < 4; ++m) { const unsigned lr = lrow + (unsigned)(ai * HALF + m * 16), key = lr & 63u;
                    const unsigned ro = (lr >> 6) * 4096u + d0 * 64u + 32u * ((key >> 2) & 1u) + 16u * (key >> 5) + 4u * ((key >> 3) & 3u) + (key & 3u);
#pragma unroll
                    for (int bj = 0; bj < 2; ++bj) { const f32x4 v0 = acc[ai][bj][m][0], v1 = acc[ai][bj][m][1]; const unsigned bo = ro + (unsigned)(bj * 132 * 4096);
                        const int w0 = __builtin_amdgcn_cvt_pk_fp8_f32(v0[0], v0[1], 0, false), w1 = __builtin_amdgcn_cvt_pk_fp8_f32(v0[2], v0[3], 0, false);
                        const int w2 = __builtin_amdgcn_cvt_pk_fp8_f32(v1[0], v1[1], 0, false), w3 = __builtin_amdgcn_cvt_pk_fp8_f32(v1[2], v1[3], 0, false);
                        __builtin_amdgcn_raw_buffer_store_b8((unsigned char)w0, rs, bo, 0, 0); __builtin_amdgcn_raw_buffer_store_b8((unsigned char)(w0 >> 8), rs, bo + 64u, 0, 0);
                        __builtin_amdgcn_raw_buffer_store_b8((unsigned char)w1, rs, bo + 128u, 0, 0); __builtin_amdgcn_raw_buffer_store_b8((unsigned char)(w1 >> 8), rs, bo + 192u, 0, 0);
                        __builtin_amdgcn_raw_buffer_store_b8((unsigned char)w2, rs, bo + 256u, 0, 0); __builtin_amdgcn_raw_buffer_store_b8((unsigned char)(w2 >> 8), rs, bo + 320u, 0, 0);
                        __builtin_amdgcn_raw_buffer_store_b8((unsigned char)w3, rs, bo + 384u, 0, 0); __builtin_amdgcn_raw_buffer_store_b8((unsigned char)(w3 >> 8), rs, bo + 448u, 0, 0); } }
        }
    }
};
}
namespace att {
using bf16 = __hip_bfloat16;
using bf16x8 = __attribute__((ext_vector_type(8))) short;
using s16x4  = __attribute__((ext_vector_type(4))) short;
using f32x16 = __attribute__((ext_vector_type(16))) float;
using u32x4  = __attribute__((ext_vector_type(4))) unsigned;
using u32x2  = __attribute__((ext_vector_type(2))) unsigned;
using f32x4  = __attribute__((ext_vector_type(4))) float;
#define ATT_SBAR() __builtin_amdgcn_sched_barrier(0)
constexpr float THR = 8.f;
__device__ __forceinline__ int crow(int r, int hi) { return (r & 3) + 8 * (r >> 2) + 4 * hi; }
__device__ __forceinline__ unsigned cvtpk(float lo, float hi) { unsigned r; asm volatile("v_cvt_pk_bf16_f32 %0, %1, %2" : "=v"(r) : "v"(lo), "v"(hi)); return r; }
__device__ __forceinline__ void partialSM(f32x16& p0, f32x16& p1, float& m_reg, float& alpha) {
  float pmax = p0[0];
#pragma unroll
  for (int r = 1; r < 16; ++r) pmax = fmaxf(pmax, p0[r]);
#pragma unroll
  for (int r = 0; r < 16; ++r) pmax = fmaxf(pmax, p1[r]);
  { auto rr = __builtin_amdgcn_permlane32_swap(__float_as_uint(pmax), __float_as_uint(pmax), false, false); pmax = fmaxf(__uint_as_float(rr[0]), __uint_as_float(rr[1])); }
  if (__builtin_expect(__all(pmax - m_reg <= THR), 1)) { alpha = 1.f; }
  else { const float mn = fmaxf(m_reg, pmax); alpha = __builtin_amdgcn_exp2f(m_reg - mn); m_reg = mn; }
  const float mneg = -m_reg;
#pragma unroll
  for (int r = 0; r < 16; ++r) p0[r] += mneg;
#pragma unroll
  for (int r = 0; r < 16; ++r) p1[r] += mneg;
#pragma unroll
  for (int r = 0; r < 16; ++r) p0[r] = __builtin_amdgcn_exp2f(p0[r]);
}
__device__ __forceinline__ void finishSM(f32x16& p0, f32x16& p1, float alpha, float& l_reg, bf16x8& pa0, bf16x8& pa1, bf16x8& pa2, bf16x8& pa3) {
#pragma unroll
  for (int r = 0; r < 16; ++r) p1[r] = __builtin_amdgcn_exp2f(p1[r]);
  float ps = 0;
#pragma unroll
  for (int r = 0; r < 16; ++r) ps += p0[r];
#pragma unroll
  for (int r = 0; r < 16; ++r) ps += p1[r];
  { auto rr = __builtin_amdgcn_permlane32_swap(__float_as_uint(ps), __float_as_uint(ps), false, false); ps = __uint_as_float(rr[0]) + __uint_as_float(rr[1]); }
  l_reg = l_reg * alpha + ps;
#define ATT_PK4(P, BASE, OUT) do { unsigned a0 = cvtpk(P[BASE + 0], P[BASE + 1]), a1 = cvtpk(P[BASE + 2], P[BASE + 3]);   \
    unsigned b0 = cvtpk(P[BASE + 4], P[BASE + 5]), b1 = cvtpk(P[BASE + 6], P[BASE + 7]);                              \
    auto r0 = __builtin_amdgcn_permlane32_swap(a0, b0, false, false); auto r1 = __builtin_amdgcn_permlane32_swap(a1, b1, false, false); \
    u32x4 w = {r0[0], r1[0], r0[1], r1[1]}; OUT = *reinterpret_cast<bf16x8*>(&w); } while (0)
  ATT_PK4(p0, 0, pa0); ATT_PK4(p0, 8, pa1); ATT_PK4(p1, 0, pa2); ATT_PK4(p1, 8, pa3);
#undef ATT_PK4
}
__device__ __forceinline__ int v_st(int k, int c) { const int kk = (k & ~0xC) | ((k & 4) << 1) | ((k & 8) >> 1); return ((kk >> 3) * 2 + (c >> 5)) * 512 + ((kk & 7) * 32 + (c & 31)) * 2; }
__device__ __forceinline__ int v_rd_base(int lane) { return ((lane & 3) << 3) | (((lane >> 2) & 3) << 6) | (((lane >> 4) & 1) << 5) | (((lane >> 5) & 1) << 8); }
constexpr int v_rd_off(int d0, int ks, int half) { return d0 * 512 + ks * 2048 + half * 1024; }
template <int OFF> __device__ __forceinline__ s16x4 tr_read(int vb) { s16x4 r; asm volatile("ds_read_b64_tr_b16 %0, %1 offset:%2" : "=&v"(r) : "v"(vb), "i"(OFF) : "memory"); return r; }
template <int D0> __device__ __forceinline__ void pv_one(f32x16& od, int vb, bf16x8 pa0, bf16x8 pa1, bf16x8 pa2, bf16x8 pa3) {
  const s16x4 l0 = tr_read<v_rd_off(D0, 0, 0)>(vb), h0 = tr_read<v_rd_off(D0, 0, 1)>(vb), l1 = tr_read<v_rd_off(D0, 1, 0)>(vb), h1 = tr_read<v_rd_off(D0, 1, 1)>(vb);
  const s16x4 l2 = tr_read<v_rd_off(D0, 2, 0)>(vb), h2 = tr_read<v_rd_off(D0, 2, 1)>(vb), l3 = tr_read<v_rd_off(D0, 3, 0)>(vb), h3 = tr_read<v_rd_off(D0, 3, 1)>(vb);
  asm volatile("s_waitcnt lgkmcnt(0)" ::: "memory"); ATT_SBAR();
#define ATT_PKV(L, H) (bf16x8){L[0], L[1], L[2], L[3], H[0], H[1], H[2], H[3]}
  od = __builtin_amdgcn_mfma_f32_32x32x16_bf16(pa0, ATT_PKV(l0, h0), od, 0, 0, 0);
  od = __builtin_amdgcn_mfma_f32_32x32x16_bf16(pa1, ATT_PKV(l1, h1), od, 0, 0, 0);
  od = __builtin_amdgcn_mfma_f32_32x32x16_bf16(pa2, ATT_PKV(l2, h2), od, 0, 0, 0);
  od = __builtin_amdgcn_mfma_f32_32x32x16_bf16(pa3, ATT_PKV(l3, h3), od, 0, 0, 0);
#undef ATT_PKV
}
__device__ __forceinline__ void pv2(f32x16* o, int vb, bf16x8 pa0, bf16x8 pa1, bf16x8 pa2, bf16x8 pa3) { pv_one<0>(o[0], vb, pa0, pa1, pa2, pa3); pv_one<1>(o[1], vb, pa0, pa1, pa2, pa3); }

#define MLA_KSWZ(row, colB) ((row) * 256 + ((colB) ^ (((row) & 15) << 4)))
constexpr int MLA_NS = 5, MLA_SHM_V = 8192, MLA_SHM_K = 16384, MLA_V_OFF = 0, MLA_K_OFF = MLA_NS * MLA_SHM_V, MLA_WS_OFF = MLA_K_OFF + MLA_NS * MLA_SHM_K, MLA_LDS = MLA_WS_OFF + 8 * 64 * 4;
__device__ __forceinline__ void mla_qkt(f32x16& p0, f32x16& p1, const char* Ks, const bf16x8* qr, const f32x16& negm, int r32, int hi) {
#pragma unroll
  for (int d0 = 0; d0 < 6; ++d0) { const int cb = (d0 * 16 + hi * 8) * 2;
    const bf16x8 b0 = *reinterpret_cast<const bf16x8*>(Ks + MLA_KSWZ(r32, cb));
    const bf16x8 b1 = *reinterpret_cast<const bf16x8*>(Ks + MLA_KSWZ(32 + r32, cb));
    if (d0 == 0) { p0 = __builtin_amdgcn_mfma_f32_32x32x16_bf16(b0, qr[0], negm, 0, 0, 0); p1 = __builtin_amdgcn_mfma_f32_32x32x16_bf16(b1, qr[0], negm, 0, 0, 0); }
    else { p0 = __builtin_amdgcn_mfma_f32_32x32x16_bf16(b0, qr[d0], p0, 0, 0, 0); p1 = __builtin_amdgcn_mfma_f32_32x32x16_bf16(b1, qr[d0], p1, 0, 0, 0); } }
}
__device__ __forceinline__ void mla_partialSM(f32x16& p0, f32x16& p1, float& m_reg, f32x16& negm, float& alpha) {
  float pmax = p0[0];
#pragma unroll
  for (int r = 1; r < 16; ++r) pmax = fmaxf(pmax, p0[r]);
#pragma unroll
  for (int r = 0; r < 16; ++r) pmax = fmaxf(pmax, p1[r]);
  { auto rr = __builtin_amdgcn_permlane32_swap(__float_as_uint(pmax), __float_as_uint(pmax), false, false); pmax = fmaxf(__uint_as_float(rr[0]), __uint_as_float(rr[1])); }
  alpha = 1.f;
  if (__builtin_expect(!__all(pmax <= THR), 0)) { const float dl = fmaxf(pmax, 0.f); m_reg += dl; alpha = __builtin_amdgcn_exp2f(-dl);
#pragma unroll
    for (int r = 0; r < 16; ++r) { p0[r] -= dl; p1[r] -= dl; }
#pragma unroll
    for (int r = 0; r < 16; ++r) negm[r] = -m_reg; }
#pragma unroll
  for (int r = 0; r < 16; ++r) p0[r] = __builtin_amdgcn_exp2f(p0[r]);
}
__device__ __forceinline__ void mla_unit(const bf16* __restrict__ Q, const bf16* __restrict__ KN, const bf16* __restrict__ KR, const bf16* __restrict__ V, unsigned char* __restrict__ O, const float* __restrict__ rope, int b, int h, int qrow0, char* lds, const int wv) {
  const int tid = opaque_tid(wv), wid = tid >> 6, lane = tid & 63, r32 = lane & 31, hi = lane >> 5;
  char* V_lds = lds + MLA_V_OFF; char* K_lds = lds + MLA_K_OFF;
  float* ws = (float*)(lds + MLA_WS_OFF) + wid * 64; float* li_l = ws; float* al_l = ws + 32;
  float m_reg = 0.f, l_reg = 0; f32x16 o[2] = {}; bf16x8 qr[6]; f32x16 negm = {};
  const bf16* Qw = Q + (size_t)(qrow0 + wid * 32 + r32) * 1536 + h * 96 + hi * 8;
#pragma unroll
  for (int d0 = 0; d0 < 6; ++d0) qr[d0] = *reinterpret_cast<const bf16x8*>(Qw + d0 * 16);
  { const unsigned s = (unsigned)(qrow0 + wid * 32 + r32) & 8191u;
#pragma unroll
    for (int d0 = 4; d0 < 6; ++d0) { const float* tp = rope + (s * 16u + (unsigned)(8 * (d0 - 4) + 4 * hi)) * 2u; const f32x4 t0 = *reinterpret_cast<const f32x4*>(tp), t1 = *reinterpret_cast<const f32x4*>(tp + 4);
      float e[8];
#pragma unroll
      for (int j = 0; j < 8; ++j) e[j] = __uint_as_float(((unsigned)(unsigned short)qr[d0][j]) << 16);
      u32x4 w; w.x = cvtpk(e[0] * t0[0] - e[1] * t0[1], e[0] * t0[1] + e[1] * t0[0]); w.y = cvtpk(e[2] * t0[2] - e[3] * t0[3], e[2] * t0[3] + e[3] * t0[2]);
      w.z = cvtpk(e[4] * t1[0] - e[5] * t1[1], e[4] * t1[1] + e[5] * t1[0]); w.w = cvtpk(e[6] * t1[2] - e[7] * t1[3], e[6] * t1[3] + e[7] * t1[2]);
      qr[d0] = *reinterpret_cast<bf16x8*>(&w); } }
  const int sr = tid >> 3, c8 = tid & 7;
  const int vst = v_st(sr, c8 * 8), kst = MLA_KSWZ(sr, c8 * 16), krst = MLA_KSWZ(sr, 128 + (c8 >> 1) * 16) + (c8 & 1) * 8;
  const int vb0 = (int)(uintptr_t)V_lds + v_rd_base(lane);
  struct { bf16x8 v, kn; u32x2 kr; } st_[1];
  const size_t lat0 = (size_t)b * 8192, ctx0 = (size_t)65536 + (size_t)b * 256;
#define MLA_TOK(t) ((t) < 128 ? lat0 + (size_t)(t) * 64 : ctx0 + (size_t)((t) - 128) * 64)
#define MLA_SLOAD(i, t) do { const size_t tk = MLA_TOK(t) + sr; st_[i].v = *reinterpret_cast<const bf16x8*>(V + tk * 1024 + h * 64 + c8 * 8); \
    st_[i].kn = *reinterpret_cast<const bf16x8*>(KN + tk * 1024 + h * 64 + c8 * 8); st_[i].kr = *reinterpret_cast<const u32x2*>(KR + tk * 32 + c8 * 4); } while (0)
#define MLA_SWRITE(slot, i) do { *(bf16x8*)(V_lds + (slot) * MLA_SHM_V + vst) = st_[i].v; *(bf16x8*)(K_lds + (slot) * MLA_SHM_K + kst) = st_[i].kn; *(u32x2*)(K_lds + (slot) * MLA_SHM_K + krst) = st_[i].kr; } while (0)
#define MLA_RESC(a) do { if (__any((a) < 1.f)) { if (hi == 0) al_l[r32] = (a); asm volatile("s_waitcnt lgkmcnt(0)" ::: "memory"); \
    _Pragma("unroll") for (int d = 0; d < 2; ++d) _Pragma("unroll") for (int r = 0; r < 16; ++r) o[d][r] *= al_l[crow(r, hi)]; } } while (0)
  f32x16 pA0, pA1, pB0, pB1; float alA, alB; bf16x8 pa0, pa1, pa2, pa3; constexpr int NT = 132;
#define MLA_INC(x) ((x) == MLA_NS - 1 ? 0 : (x) + 1)
  MLA_SLOAD(0, 0); MLA_SWRITE(0, 0); MLA_SLOAD(0, 1); MLA_SWRITE(1, 0); MLA_SLOAD(0, 2); MLA_SWRITE(2, 0); MLA_SLOAD(0, 3);
  __syncthreads();
  mla_qkt(pA0, pA1, K_lds, qr, negm, r32, hi); mla_partialSM(pA0, pA1, m_reg, negm, alA);
  int s0 = 0;
  for (int t = 1; t + 1 < NT; t += 2) {
    const int s1 = MLA_INC(s0), s2 = MLA_INC(s1), s3 = MLA_INC(s2), s4 = MLA_INC(s3);
    __syncthreads();
    MLA_SWRITE(s3, 0); if (t + 3 < NT) MLA_SLOAD(0, t + 3);
    ATT_SBAR(); mla_qkt(pB0, pB1, K_lds + s1 * MLA_SHM_K, qr, negm, r32, hi);
    finishSM(pA0, pA1, alA, l_reg, pa0, pa1, pa2, pa3); ATT_SBAR();
    pv2(o, vb0 + s0 * MLA_SHM_V, pa0, pa1, pa2, pa3); mla_partialSM(pB0, pB1, m_reg, negm, alB);
    MLA_RESC(alB);
    if (t + 3 < NT) { MLA_SWRITE(s4, 0); if (t + 4 < NT) MLA_SLOAD(0, t + 4); }
    ATT_SBAR(); mla_qkt(pA0, pA1, K_lds + s2 * MLA_SHM_K, qr, negm, r32, hi);
    finishSM(pB0, pB1, alB, l_reg, pa0, pa1, pa2, pa3); ATT_SBAR();
    pv2(o, vb0 + s1 * MLA_SHM_V, pa0, pa1, pa2, pa3); mla_partialSM(pA0, pA1, m_reg, negm, alA);
    MLA_RESC(alA);
    s0 = s2;
  }
  { const int s1 = MLA_INC(s0);
    __syncthreads();
    ATT_SBAR(); mla_qkt(pB0, pB1, K_lds + s1 * MLA_SHM_K, qr, negm, r32, hi);
    finishSM(pA0, pA1, alA, l_reg, pa0, pa1, pa2, pa3); ATT_SBAR();
    pv2(o, vb0 + s0 * MLA_SHM_V, pa0, pa1, pa2, pa3); mla_partialSM(pB0, pB1, m_reg, negm, alB);
    MLA_RESC(alB);
    finishSM(pB0, pB1, alB, l_reg, pa0, pa1, pa2, pa3); ATT_SBAR();
    pv2(o, vb0 + s1 * MLA_SHM_V, pa0, pa1, pa2, pa3); }
#undef MLA_INC
  if (hi == 0) li_l[r32] = l_reg; asm volatile("s_waitcnt lgkmcnt(0)" ::: "memory");
  float rli[16];
#pragma unroll
  for (int r = 0; r < 16; ++r) rli[r] = __builtin_amdgcn_rcpf(li_l[crow(r, hi)]);
  unsigned char* Ow = O + (size_t)(qrow0 + wid * 32) * 1024 + h * 64;
#pragma unroll
  for (int r = 0; r < 16; ++r) { const int orow = crow(r, hi);
#pragma unroll
    for (int d0 = 0; d0 < 2; ++d0) Ow[(size_t)orow * 1024 + d0 * 32 + r32] = (unsigned char)__builtin_amdgcn_cvt_pk_fp8_f32(o[d0][r] * rli[r], 0.f, 0, false); }
  __syncthreads();
#undef MLA_TOK
#undef MLA_SLOAD
#undef MLA_SWRITE
#undef MLA_RESC
}

typedef int v8i __attribute__((ext_vector_type(8)));
typedef int v4i __attribute__((ext_vector_type(4)));
constexpr int M8_NS = 5, M8_KP = 144, M8_K_BYTES = 64 * M8_KP, M8_VP = 80, M8_V_BYTES = 64 * M8_VP, M8_V_OFF = 0, M8_K_OFF = M8_NS * M8_V_BYTES, M8_WS_OFF = M8_K_OFF + M8_NS * M8_K_BYTES, M8_LDS = M8_WS_OFF + 8 * 64 * 4;
#define M8_CAT(x, y) __builtin_shufflevector(x, y, 0, 1, 2, 3, 4, 5, 6, 7)
#define M8_MFMA(a, b, c) __builtin_amdgcn_mfma_scale_f32_32x32x64_f8f6f4(a, b, c, 0, 0, 0, 0x7f7f7f7f, 0, 0x7f7f7f7f)
__device__ __forceinline__ unsigned pk8(float a, float b, float c, float d) { int w = __builtin_amdgcn_cvt_pk_fp8_f32(a, b, 0, false); w = __builtin_amdgcn_cvt_pk_fp8_f32(c, d, w, true); return (unsigned)w; }
__device__ __forceinline__ void mla8_qkt(f32x16& p0, f32x16& p1, const char* Ks, const v8i& qa, const v8i& qb, const f32x16& negm, int r32, int hi) {
  const char* k0 = Ks + r32 * M8_KP + 32 * hi; const char* k1 = k0 + 32 * M8_KP;
  const v8i a0 = M8_CAT(*reinterpret_cast<const v4i*>(k0), *reinterpret_cast<const v4i*>(k0 + 16)), a1 = M8_CAT(*reinterpret_cast<const v4i*>(k1), *reinterpret_cast<const v4i*>(k1 + 16));
  const v8i b0 = M8_CAT(*reinterpret_cast<const v4i*>(k0 + 64), *reinterpret_cast<const v4i*>(k0 + 80)), b1 = M8_CAT(*reinterpret_cast<const v4i*>(k1 + 64), *reinterpret_cast<const v4i*>(k1 + 80));
  p0 = M8_MFMA(a0, qa, negm); p1 = M8_MFMA(a1, qa, negm);
  p0 = M8_MFMA(b0, qb, p0);   p1 = M8_MFMA(b1, qb, p1);
}
__device__ __forceinline__ void mla8_finishSM(f32x16& p0, f32x16& p1, v8i& pa) {
#pragma unroll
  for (int r = 0; r < 16; ++r) p1[r] = __builtin_amdgcn_exp2f(p1[r]);
#pragma unroll
  for (int i = 0; i < 4; ++i) { pa[i] = (int)pk8(p0[4 * i], p0[4 * i + 1], p0[4 * i + 2], p0[4 * i + 3]); pa[4 + i] = (int)pk8(p1[4 * i], p1[4 * i + 1], p1[4 * i + 2], p1[4 * i + 3]); }
}
__device__ __forceinline__ void mla8_pv(f32x16* o, const char* Vs, const v8i& pa, int r32, int hi) {
  const char* v0 = Vs + r32 * M8_VP + 32 * hi; const char* v1 = v0 + 32 * M8_VP;
  const v8i f0 = M8_CAT(*reinterpret_cast<const v4i*>(v0), *reinterpret_cast<const v4i*>(v0 + 16)), f1 = M8_CAT(*reinterpret_cast<const v4i*>(v1), *reinterpret_cast<const v4i*>(v1 + 16));
  o[0] = M8_MFMA(pa, f0, o[0]); o[1] = M8_MFMA(pa, f1, o[1]);
  const v8i ones = {0x38383838, 0x38383838, 0x38383838, 0x38383838, 0x38383838, 0x38383838, 0x38383838, 0x38383838};
  o[2] = M8_MFMA(pa, ones, o[2]);
}
__device__ __forceinline__ void mla8_zero_pad(char* lds, const int wv) {
  const int tid = opaque_tid(wv); char* K_lds = lds + M8_K_OFF;
  for (int i = tid; i < M8_NS * 64 * 2; i += 512) { const int slot = i >> 7, row = (i >> 1) & 63, q = i & 1; *reinterpret_cast<v4i*>(K_lds + slot * M8_K_BYTES + row * M8_KP + 96 + 16 * q) = (v4i){0, 0, 0, 0}; }
  __syncthreads();
}
__device__ __forceinline__ unsigned pk8n(float a, float b, float c, float d) { int w = __builtin_amdgcn_cvt_pk_fp8_f32(a, b, __float_as_int(a), false); w = __builtin_amdgcn_cvt_pk_fp8_f32(c, d, w, true); return (unsigned)w; }
__device__ __forceinline__ float max3f(float a, float b, float c) { float d; asm volatile("v_max3_f32 %0, %1, %2, %3" : "=v"(d) : "v"(a), "v"(b), "v"(c)); return d; }
__device__ __forceinline__ float max16(float s, const f32x16& p) {
#pragma unroll
  for (int r = 0; r < 16; r += 2) s = max3f(s, p[r], p[r + 1]);
  return s;
}
__device__ __forceinline__ void mla8_unit(const bf16* __restrict__ Q, const unsigned char* __restrict__ K8, const unsigned char* __restrict__ KR8, const unsigned char* __restrict__ V8, unsigned char* __restrict__ O,
                                          const float* __restrict__ rope, int b, int h, int qrow0, char* lds, const int wv) {
  const int tid = opaque_tid(wv), wid = tid >> 6, lane = tid & 63, r32 = lane & 31, hi = lane >> 5;
  char* V_lds = lds + M8_V_OFF; char* K_lds = lds + M8_K_OFF;
  float* ws = (float*)(lds + M8_WS_OFF) + wid * 64; float* al_l = ws + 32;
  f32x16 o[3] = {}; f32x16 negm = {};
  v8i qa, qb;
  { const bf16* Qw = Q + (size_t)(qrow0 + wid * 32 + r32) * 1536 + h * 96;
    float e[32];
#pragma unroll
    for (int c = 0; c < 4; ++c) { const bf16x8 v = *reinterpret_cast<const bf16x8*>(Qw + 32 * hi + 8 * c);
#pragma unroll
      for (int j = 0; j < 8; ++j) e[8 * c + j] = __uint_as_float(((unsigned)(unsigned short)v[j]) << 16); }
#pragma unroll
    for (int i = 0; i < 8; ++i) qa[i] = (int)pk8(e[4 * i], e[4 * i + 1], e[4 * i + 2], e[4 * i + 3]);
#pragma unroll
    for (int c = 0; c < 4; ++c) { const bf16x8 v = *reinterpret_cast<const bf16x8*>(Qw + 64 + 8 * c);
#pragma unroll
      for (int j = 0; j < 8; ++j) e[8 * c + j] = __uint_as_float(((unsigned)(unsigned short)v[j]) << 16); }
    const float* tp = rope + (size_t)((unsigned)(qrow0 + wid * 32 + r32) & 8191u) * 32;
#pragma unroll
    for (int c = 0; c < 8; ++c) { const f32x4 t = *reinterpret_cast<const f32x4*>(tp + 4 * c);
      const float x0 = e[4 * c], x1 = e[4 * c + 1], x2 = e[4 * c + 2], x3 = e[4 * c + 3];
      e[4 * c] = x0 * t[0] - x1 * t[1]; e[4 * c + 1] = x0 * t[1] + x1 * t[0]; e[4 * c + 2] = x2 * t[2] - x3 * t[3]; e[4 * c + 3] = x2 * t[3] + x3 * t[2]; }
#pragma unroll
    for (int i = 0; i < 8; ++i) qb[i] = hi ? 0 : (int)pk8(e[4 * i], e[4 * i + 1], e[4 * i + 2], e[4 * i + 3]); }
  const int wsc = __builtin_amdgcn_readfirstlane(wid); const bool knope = wsc < 4; const bool kdo = wsc < 6;
  const int kkey = knope ? (tid >> 2) : ((tid - 256) >> 1), kch = knope ? (tid & 3) : 4 + (tid & 1);
  const int kst = kkey * M8_KP + kch * 16;
  const unsigned char* kbase = knope ? K8 + h * 64 : KR8; const unsigned kstride = knope ? 1024u : 32u; const unsigned kvoff = knope ? (unsigned)(kkey * 1024 + kch * 16) : (unsigned)(kkey * 32 + (kch - 4) * 16);
  const bool vdo = wsc < 4; const int vd = (tid >> 2) & 63, vc = tid & 3;
  const int vst = vd * M8_VP + 16 * vc; const unsigned vvoff = (unsigned)(vd * 64 + 16 * vc);
  v4i skv = {0, 0, 0, 0}, svv = {0, 0, 0, 0}, skw = {0, 0, 0, 0}, svw = {0, 0, 0, 0};
  const unsigned char* vblk0 = V8 + (size_t)((b * 16 + h) * 132) * 4096;
  const unsigned lat0 = (unsigned)b * 8192u, ctx0 = 65536u + (unsigned)b * 256u;
#define M8_TOK(t) ((t) < 128 ? lat0 + (unsigned)(t) * 64u : ctx0 + (unsigned)((t) - 128) * 64u)
#define M8_SLOADX(t, KV, VV) do { const unsigned tk0 = M8_TOK(t); if (kdo) KV = *reinterpret_cast<const v4i*>(kbase + (size_t)tk0 * kstride + kvoff); \
    if (vdo) VV = *reinterpret_cast<const v4i*>(vblk0 + (size_t)(t) * 4096 + vvoff); } while (0)
#define M8_SWRITEX(slot, KV, VV) do { if (kdo) *reinterpret_cast<v4i*>(K_lds + (slot) * M8_K_BYTES + kst) = KV; if (vdo) *reinterpret_cast<v4i*>(V_lds + (slot) * M8_V_BYTES + vst) = VV; } while (0)
#define M8_SLOAD(t) M8_SLOADX(t, skv, svv)
#define M8_SWRITE(slot) M8_SWRITEX(slot, skv, svv)
#define M8_RESC(a) do { if (__any((a) < 1.f)) { if (hi == 0) al_l[r32] = (a); asm volatile("s_waitcnt lgkmcnt(0)" ::: "memory"); \
    _Pragma("unroll") for (int r = 0; r < 16; ++r) { const float f_ = al_l[crow(r, hi)]; o[0][r] *= f_; o[1][r] *= f_; o[2][r] *= f_; } } } while (0)
#define M8_INC(x) ((x) == M8_NS - 1 ? 0 : (x) + 1)
  f32x16 pX0, pA1, pB1; constexpr int NT = 132;
  v8i ka, kb, kc, kd, f0, f1;
  v8i ones8 = {0x38383838, 0x38383838, 0x38383838, 0x38383838, 0x38383838, 0x38383838, 0x38383838, 0x38383838}; asm volatile("" : "+v"(ones8));
#define M8_SB() __builtin_amdgcn_sched_barrier(0)
#define M8_PIN(x) asm volatile("" : "+v"(x))
#define M8_LDK(s) do { const char* k0_ = K_lds + (s) * M8_K_BYTES + r32 * M8_KP + 32 * hi; const char* k1_ = k0_ + 32 * M8_KP; \
    ka = M8_CAT(*reinterpret_cast<const v4i*>(k0_), *reinterpret_cast<const v4i*>(k0_ + 16)); kc = M8_CAT(*reinterpret_cast<const v4i*>(k1_), *reinterpret_cast<const v4i*>(k1_ + 16)); \
    kb = M8_CAT(*reinterpret_cast<const v4i*>(k0_ + 64), *reinterpret_cast<const v4i*>(k0_ + 80)); kd = M8_CAT(*reinterpret_cast<const v4i*>(k1_ + 64), *reinterpret_cast<const v4i*>(k1_ + 80)); } while (0)
#define M8_LDV(s) do { const char* v0_ = V_lds + (s) * M8_V_BYTES + r32 * M8_VP + 32 * hi; const char* v1_ = v0_ + 32 * M8_VP; \
    f0 = M8_CAT(*reinterpret_cast<const v4i*>(v0_), *reinterpret_cast<const v4i*>(v0_ + 16)); f1 = M8_CAT(*reinterpret_cast<const v4i*>(v1_), *reinterpret_cast<const v4i*>(v1_ + 16)); } while (0)
#define M8_EX(P, I) P[I] = __builtin_amdgcn_exp2f(P[I])
#define M8_PK(P, I, W) W = (int)pk8n(P[I], P[I + 1], P[I + 2], P[I + 3])
#define M8_E4(P, I, W) do { M8_EX(P, I); M8_EX(P, I + 1); M8_EX(P, I + 2); M8_EX(P, I + 3); M8_PK(P, I, W); } while (0)
#define M8_PIN2(a_, b_) asm volatile("" : "+v"(a_), "+v"(b_))
#define M8_PIN4(a_, b_, c_, d_) asm volatile("" : "+v"(a_), "+v"(b_), "+v"(c_), "+v"(d_))
#define M8_PIN6(a_, b_, c_, d_, e_, f_) asm volatile("" : "+v"(a_), "+v"(b_), "+v"(c_), "+v"(d_), "+v"(e_), "+v"(f_))
#define M8_TAIL(C0, C1, PN, MX) do { \
    if (__builtin_expect(!__all((MX) <= THR), 0)) { const float dl_ = fmaxf((MX), 0.f); const float al_ = __builtin_amdgcn_exp2f(-dl_); \
      _Pragma("unroll") for (int r_ = 0; r_ < 16; ++r_) { C0[r_] -= dl_; C1[r_] -= dl_; negm[r_] -= dl_; } \
      if (hi == 0) al_l[r32] = al_; asm volatile("s_waitcnt lgkmcnt(0)" ::: "memory"); \
      _Pragma("unroll") for (int r_ = 0; r_ < 16; ++r_) { const float f_ = al_l[crow(r_, hi)]; o[0][r_] *= f_; o[1][r_] *= f_; o[2][r_] *= f_; } } \
    _Pragma("unroll") for (int r_ = 0; r_ < 16; ++r_) M8_EX(C0, r_); \
    M8_PK(C0, 0, PN[0]); M8_PK(C0, 4, PN[1]); M8_PK(C0, 8, PN[2]); M8_PK(C0, 12, PN[3]); } while (0)
#define M8_MX8(P, I) max3f(max3f(max3f(P[I], P[I + 1], P[I + 2]), P[I + 3], P[I + 4]), max3f(P[I + 5], P[I + 6], P[I + 7]), P[I + 5])
#define M8_MXFIN(MX) do { auto rr_ = __builtin_amdgcn_permlane32_swap(__float_as_uint(MX), __float_as_uint(MX), false, false); MX = max3f(__uint_as_float(rr_[0]), __uint_as_float(rr_[1]), __uint_as_float(rr_[1])); } while (0)
#define M8_HALF(C0, C1, PC, PN, PRV1, VS, NEXTK) do { float mxa_, mxb_; \
    M8_PIN(PRV1); M8_LDV(VS); M8_SB(); \
    C0 = M8_MFMA(ka, qa, negm); M8_SB(); M8_EX(PRV1, 0); M8_EX(PRV1, 1); M8_EX(PRV1, 2); M8_EX(PRV1, 3); M8_EX(PRV1, 4); M8_EX(PRV1, 5); M8_PIN6(PRV1[0], PRV1[1], PRV1[2], PRV1[3], PRV1[4], PRV1[5]); M8_SB(); \
    C1 = M8_MFMA(kc, qa, negm); M8_SB(); M8_EX(PRV1, 6); M8_EX(PRV1, 7); M8_EX(PRV1, 8); M8_EX(PRV1, 9); M8_EX(PRV1, 10); M8_EX(PRV1, 11); M8_PK(PRV1, 0, PC[4]); M8_PIN6(PRV1[6], PRV1[7], PRV1[8], PRV1[9], PRV1[10], PRV1[11]); M8_PIN(PC[4]); M8_SB(); \
    C0 = M8_MFMA(kb, qb, C0);   M8_SB(); M8_EX(PRV1, 12); M8_EX(PRV1, 13); M8_EX(PRV1, 14); M8_EX(PRV1, 15); M8_PK(PRV1, 4, PC[5]); M8_PK(PRV1, 8, PC[6]); M8_PIN4(PRV1[12], PRV1[13], PRV1[14], PRV1[15]); M8_PIN2(PC[5], PC[6]); M8_SB(); \
    C1 = M8_MFMA(kd, qb, C1);   M8_SB(); M8_PK(PRV1, 12, PC[7]); M8_PIN(PC[7]); M8_SB(); \
    o[0] = M8_MFMA(PC, f0, o[0]);    M8_SB(); mxa_ = M8_MX8(C0, 0); mxb_ = M8_MX8(C0, 8); M8_SB(); \
    o[1] = M8_MFMA(PC, f1, o[1]);    M8_SB(); mxa_ = max3f(mxa_, M8_MX8(C1, 0), mxb_); mxb_ = M8_MX8(C1, 8); M8_SB(); \
    o[2] = M8_MFMA(PC, ones8, o[2]); M8_SB(); \
    NEXTK; mxa_ = max3f(mxa_, mxb_, mxb_); M8_MXFIN(mxa_); M8_SB(); \
    M8_TAIL(C0, C1, PN, mxa_); } while (0)
  v8i paA, paB;
  M8_SLOAD(0); M8_SWRITE(0); M8_SLOAD(1); M8_SWRITE(1); M8_SLOAD(2); M8_SWRITE(2); M8_SLOAD(3); M8_SLOADX(4, skw, svw);
  __syncthreads();
  { M8_LDK(0); pX0 = M8_MFMA(ka, qa, negm); pA1 = M8_MFMA(kc, qa, negm); pX0 = M8_MFMA(kb, qb, pX0); pA1 = M8_MFMA(kd, qb, pA1);
    asm volatile("s_nop 15\n\ts_nop 15\n\ts_nop 15\n\ts_nop 15\n\ts_nop 15" ::: "memory");
    float mx_ = max16(max16(pX0[0], pX0), pA1); M8_MXFIN(mx_);
    M8_LDK(1);
    M8_TAIL(pX0, pA1, paA, mx_); }
  int s0 = 0;
#pragma unroll 1
  for (int t = 1; t + 1 < NT; t += 2) {
    const int s1 = M8_INC(s0), s2 = M8_INC(s1), s3 = M8_INC(s2), s4 = M8_INC(s3);
    M8_SWRITE(s3); if (t + 4 < NT) M8_SLOAD(t + 4);
    M8_HALF(pX0, pB1, paA, paB, pA1, s0, M8_LDK(s2));
    if (t + 3 < NT) { M8_SWRITEX(s4, skw, svw); if (t + 5 < NT) M8_SLOADX(t + 5, skw, svw); }
    M8_HALF(pX0, pA1, paB, paA, pB1, s1, (void)0);
    __syncthreads(); M8_LDK(s3);
    s0 = s2;
  }
  { const int s1 = M8_INC(s0);
    M8_HALF(pX0, pB1, paA, paB, pA1, s0, (void)0);
    M8_PIN(pB1); M8_LDV(s1);
    M8_E4(pB1, 0, paB[4]); M8_E4(pB1, 4, paB[5]); M8_E4(pB1, 8, paB[6]); M8_E4(pB1, 12, paB[7]);
    o[0] = M8_MFMA(paB, f0, o[0]); o[1] = M8_MFMA(paB, f1, o[1]); o[2] = M8_MFMA(paB, ones8, o[2]); }
#undef M8_SB
#undef M8_PIN
#undef M8_LDK
#undef M8_LDV
#undef M8_E4
#undef M8_EX
#undef M8_PK
#undef M8_PIN2
#undef M8_PIN4
#undef M8_PIN6
#undef M8_MX8
#undef M8_TAIL
#undef M8_MXFIN
#undef M8_HALF
  float rli[16];
#pragma unroll
  for (int r = 0; r < 16; ++r) rli[r] = __builtin_amdgcn_rcpf(o[2][r]);
  const int tid_e = opaque_tid(wv), r32e = tid_e & 31, hie = (tid_e >> 5) & 1;
  unsigned char* Ow = O + (size_t)(qrow0 + (tid_e >> 6) * 32) * 1024 + h * 64;
#pragma unroll
  for (int r = 0; r < 16; ++r) { const int orow = crow(r, hie);
#pragma unroll
    for (int d0 = 0; d0 < 2; ++d0) Ow[(size_t)orow * 1024 + d0 * 32 + r32e] = (unsigned char)__builtin_amdgcn_cvt_pk_fp8_f32(o[d0][r] * rli[r], 0.f, 0, false); }
  __syncthreads();
#undef M8_TOK
#undef M8_SLOAD
#undef M8_SLOADX
#undef M8_SWRITEX
#undef M8_SWRITE
#undef M8_RESC
#undef M8_INC
}

#define NA_KSWZ(row, colB) ((row) * 128 + ((colB) ^ ((((row) >> 1) & 7) << 4)))
constexpr int NA_K_OFF = 0, NA_V_OFF = 32768, NA_SLOT = 65536, NA_RPB_OFF = 2 * NA_SLOT, NA_RPB_STRIDE = 576, NA_RPB_PAD = 48, NA_WS_OFF = NA_RPB_OFF + 4 * NA_RPB_STRIDE * 4, NA_LDS = NA_WS_OFF + 8 * 64 * 4;
__device__ __forceinline__ void na_qkt(f32x16& p0, f32x16& p1, const char* Ks, const bf16x8* qr, const f32x16& negm, int r32, int hi) {
#pragma unroll
  for (int d0 = 0; d0 < 4; ++d0) { const int cb = (d0 * 16 + hi * 8) * 2;
    const bf16x8 b0 = *reinterpret_cast<const bf16x8*>(Ks + NA_KSWZ(r32, cb));
    const bf16x8 b1 = *reinterpret_cast<const bf16x8*>(Ks + NA_KSWZ(32 + r32, cb));
    if (d0 == 0) { p0 = __builtin_amdgcn_mfma_f32_32x32x16_bf16(b0, qr[0], negm, 0, 0, 0); p1 = __builtin_amdgcn_mfma_f32_32x32x16_bf16(b1, qr[0], negm, 0, 0, 0); }
    else { p0 = __builtin_amdgcn_mfma_f32_32x32x16_bf16(b0, qr[d0], p0, 0, 0, 0); p1 = __builtin_amdgcn_mfma_f32_32x32x16_bf16(b1, qr[d0], p1, 0, 0, 0); } }
}
__device__ __forceinline__ void na_partialSM(f32x16& p0, f32x16& p1, f32x16& negm, float& alpha, bool first) {
  float pmax = p0[0];
#pragma unroll
  for (int r = 1; r < 16; ++r) pmax = fmaxf(pmax, p0[r]);
#pragma unroll
  for (int r = 0; r < 16; ++r) pmax = fmaxf(pmax, p1[r]);
  { auto rr = __builtin_amdgcn_permlane32_swap(__float_as_uint(pmax), __float_as_uint(pmax), false, false); pmax = fmaxf(__uint_as_float(rr[0]), __uint_as_float(rr[1])); }
  alpha = 1.f;
  if (__builtin_expect(first || !__all(pmax <= THR), 0)) { const float dl = first ? pmax : fmaxf(pmax, 0.f); alpha = first ? 1.f : __builtin_amdgcn_exp2f(-dl);
#pragma unroll
    for (int r = 0; r < 16; ++r) { p0[r] -= dl; p1[r] -= dl; negm[r] -= dl; } }
#pragma unroll
  for (int r = 0; r < 16; ++r) p0[r] = __builtin_amdgcn_exp2f(p0[r]);
}
__device__ __forceinline__ void na_unit(const bf16* __restrict__ Q, const bf16* __restrict__ K, const bf16* __restrict__ V, bf16* __restrict__ O, const float* __restrict__ rpb,
                                        int b, int r, int hg, int is_ctx, char* lds, const int wv) {
  const int tid = opaque_tid(wv), wid = tid >> 6, lane = tid & 63, r32 = lane & 31, hi = lane >> 5;
  const int hh = wid >> 1, half = wid & 1, h = hg * 4 + hh;
  char* Kw = lds + NA_K_OFF + hh * 8192; char* Vw = lds + NA_V_OFF + hh * 8192;
  const float* rpbw = (const float*)(lds + NA_RPB_OFF) + hh * NA_RPB_STRIDE + NA_RPB_PAD;
  float* ws = (float*)(lds + NA_WS_OFF) + wid * 64; float* li_l = ws; float* al_l = ws + 32;
  const size_t lat0 = (size_t)b * 8192, ctx0 = (size_t)65536 + (size_t)b * 256;
  const size_t qtok0 = is_ctx ? ctx0 + (size_t)r * 64 + half * 32 : lat0 + (size_t)r * 64 + half * 32;
  int wstart = r - 4; wstart = wstart < 0 ? 0 : (wstart > 120 ? 120 : wstart);
  const int t0 = is_ctx ? 8 : 0;
  for (int i = tid; i < 4 * NA_RPB_STRIDE; i += 512) { const int hq = i / NA_RPB_STRIDE, w = i % NA_RPB_STRIDE - NA_RPB_PAD; ((float*)(lds + NA_RPB_OFF))[i] = (w >= 0 && w < 465) ? rpb[(size_t)(hg * 4 + hq) * 465 + w] * 1.4426950408889634f : 0.f; }
  float l_reg = 0; f32x16 o[2] = {}; f32x16 negm = {}; bf16x8 qr[4];
  const bf16* Qw = Q + (qtok0 + r32) * 1024 + h * 64 + hi * 8;
#pragma unroll
  for (int d0 = 0; d0 < 4; ++d0) qr[d0] = *reinterpret_cast<const bf16x8*>(Qw + d0 * 16);
  const int srow = tid >> 5, within = tid & 31, shh = within >> 3, sch = within & 7;
  bf16x8 kreg[4], vreg[4];
  const unsigned lat0u = (unsigned)b * 8192u, ctx0u = 65536u + (unsigned)b * 256u;
  const unsigned sloff = (unsigned)((srow * 1024 + hg * 256 + within * 8) * 2);
#define NA_TOK(t) ((t) < 8 ? lat0u + (unsigned)(wstart + (t)) * 64u : ctx0u + (unsigned)((t) - 8) * 64u)
#define NA_SLOAD(t) do { const unsigned tk = NA_TOK(t); _Pragma("unroll") for (int j = 0; j < 4; ++j) { const size_t gb = (size_t)(tk + 16u * j) * 2048; \
    kreg[j] = *reinterpret_cast<const bf16x8*>((const char*)K + gb + sloff); vreg[j] = *reinterpret_cast<const bf16x8*>((const char*)V + gb + sloff); } } while (0)
#define NA_SWRITE(slot) do { _Pragma("unroll") for (int j = 0; j < 4; ++j) { const int row = srow + 16 * j; *(bf16x8*)(lds + (slot) * NA_SLOT + NA_K_OFF + shh * 8192 + NA_KSWZ(row, sch * 16)) = kreg[j]; \
    *(bf16x8*)(lds + (slot) * NA_SLOT + NA_V_OFF + shh * 8192 + v_st(row, sch * 8)) = vreg[j]; } } while (0)
  const int vb = (int)(uintptr_t)Vw + v_rd_base(lane);
  const int qc = half * 32 + r32; int wcol = qc - 8; wcol = wcol < 0 ? 0 : (wcol > 48 ? 48 : wcol);
  typedef const __attribute__((address_space(3))) float* lds_cfp; lds_cfp rpbl = (lds_cfp)(rpbw + (15 - qc + 4 * hi)); asm volatile("" : "+v"(rpbl));
  float mk0[16], mk1[16];
#pragma unroll
  for (int rg = 0; rg < 16; ++rg) { const int j0 = crow(rg, hi); mk0[rg] = ((unsigned)(j0 - wcol) < 16u) ? 0.f : -INFINITY; mk1[rg] = ((unsigned)(j0 + 32 - wcol) < 16u) ? 0.f : -INFINITY; }
  NA_SLOAD(t0); NA_SWRITE(0); if (t0 + 1 < 12) NA_SLOAD(t0 + 1);
  int cur = 0;
  for (int t = t0; t < 12; ++t) {
    __syncthreads();
    if (t + 1 < 12) { NA_SWRITE(cur ^ 1); if (t + 2 < 12) NA_SLOAD(t + 2); }
    f32x16 p0, p1; float alpha; bf16x8 pa0, pa1, pa2, pa3;
    na_qkt(p0, p1, Kw + cur * NA_SLOT, qr, negm, r32, hi);
    if (t < 8) {
      lds_cfp rb = rpbl + (wstart + t - r + 7) * 31;
#pragma unroll
      for (int rg = 0; rg < 16; ++rg) { const int jc = (rg & 3) + 8 * (rg >> 2);
        p0[rg] = (p0[rg] + mk0[rg]) + rb[jc]; p1[rg] = (p1[rg] + mk1[rg]) + rb[jc + 32]; }
    }
    na_partialSM(p0, p1, negm, alpha, t == t0);
    finishSM(p0, p1, alpha, l_reg, pa0, pa1, pa2, pa3);
    if (__any(alpha < 1.f)) { if (hi == 0) al_l[r32] = alpha; asm volatile("s_waitcnt lgkmcnt(0)" ::: "memory");
#pragma unroll
      for (int d = 0; d < 2; ++d)
#pragma unroll
        for (int rg = 0; rg < 16; ++rg) o[d][rg] *= al_l[crow(rg, hi)]; }
    ATT_SBAR();
    pv2(o, vb + cur * NA_SLOT, pa0, pa1, pa2, pa3);
    cur ^= 1;
  }
  if (hi == 0) li_l[r32] = l_reg; asm volatile("s_waitcnt lgkmcnt(0)" ::: "memory");
  float rli[16];
#pragma unroll
  for (int rg = 0; rg < 16; ++rg) rli[rg] = __builtin_amdgcn_rcpf(li_l[crow(rg, hi)]);
  bf16* Ow = O + qtok0 * 1024 + h * 64;
#pragma unroll
  for (int rg = 0; rg < 16; ++rg) { const int orow = crow(rg, hi);
#pragma unroll
    for (int d0 = 0; d0 < 2; ++d0) Ow[(size_t)orow * 1024 + d0 * 32 + r32] = __float2bfloat16(o[d0][rg] * rli[rg]); }
  __syncthreads();
#undef NA_TOK
#undef NA_SLOAD
#undef NA_SWRITE
}
#undef ATT_SBAR
}
constexpr int NWAVES = 8;
#ifndef MK_PER_PHASE
#define MK_PER_PHASE 0
#endif
constexpr int DM = 1024, NB = 8, SEQ = 8192, CTXL = 256, TL = NB * SEQ, TC = NB * CTXL, T0 = TL + TC;
constexpr int NEXP = 32, TOPK = 4, DFF = 1024;
constexpr float NORM_EPS = 1e-6f;
constexpr float LOG2E = 1.4426950408889634f;
constexpr float NA_QSCALE = 0.125f * LOG2E;
constexpr float MLA_QSCALE = 0.10206207261596575f * LOG2E;
constexpr int MAX_BLOCKS = 1088;
constexpr size_t MiB = 1u << 20;
constexpr size_t WS_CTL = 0, CTL_ZERO_BYTES = 1 * MiB;
constexpr size_t WS_MOD = 1 * MiB;
constexpr size_t WS_ROPE = 2 * MiB;
constexpr size_t WS_WR = 3 * MiB;
constexpr size_t WS_WQKV = 4 * MiB;
constexpr size_t WS_WO0 = 10 * MiB;
constexpr size_t WS_WA = 12 * MiB;
constexpr size_t WS_WQB = 13 * MiB;
constexpr size_t WS_WKVB = 14 * MiB;
constexpr size_t WS_WO1 = 15 * MiB;
constexpr size_t WS_TKE = 17 * MiB, WS_TKG = 19 * MiB, WS_TKS = 21 * MiB;
constexpr size_t WS_W1 = 24 * MiB;
constexpr size_t WS_W2 = 280 * MiB;
constexpr size_t WS_XN = 408 * MiB;
constexpr size_t WS_H = 542 * MiB;
constexpr size_t WS_RA = 806 * MiB;
constexpr size_t WS_RB = 1350 * MiB;
constexpr size_t WS_END = 1894 * MiB;
constexpr size_t RA_Q = 0, RA_K = 132 * MiB, RA_V = 264 * MiB, RA_Q1 = 0, RA_KN = 192 * MiB, RA_V1 = 324 * MiB;
constexpr size_t RB_O = 0, RB_WAOUT = 0, RB_QN = 132 * MiB, RB_KVN = 164 * MiB, RB_KR = 181 * MiB, RB_O1 = 186 * MiB;
static_assert((size_t)T0 * 1024 * 2 == 132 * MiB && (size_t)MAX_BLOCKS * 256 * 1024 * 2 == 544 * MiB, "region sizes");
constexpr int CW_CNT0 = 64, CW_CNT1 = 128;
constexpr int CW_BAR = 4096;
constexpr int RING_OFF = 0, RING_BYTES = 131072;
constexpr int LDSCTL_OFF = 154624, MISC_OFF = LDSCTL_OFF + 320;
constexpr int LDS_BYTES = 155648;

#define GAS __attribute__((address_space(1)))
#define LAS __attribute__((address_space(3)))
typedef unsigned short bf16;
typedef unsigned v4u __attribute__((ext_vector_type(4)));
typedef unsigned v2u __attribute__((ext_vector_type(2)));
typedef float f32x4 __attribute__((ext_vector_type(4)));
#define LDS_WAIT() asm volatile("s_waitcnt lgkmcnt(0)" ::: "memory")
__device__ __forceinline__ unsigned f2bf(float f) { unsigned u = __builtin_bit_cast(unsigned, f); return (u + 0x7fffu + ((u >> 16) & 1u)) >> 16; }
__device__ __forceinline__ unsigned pk2(float lo, float hi) { return f2bf(lo) | (f2bf(hi) << 16); }
__device__ __forceinline__ unsigned pk_fp8x4(float a, float b, float c, float d) { int w = __builtin_amdgcn_cvt_pk_fp8_f32(a, b, 0, false); w = __builtin_amdgcn_cvt_pk_fp8_f32(c, d, w, true); return (unsigned)w; }
constexpr float W8_SCALE = 32.0f;
__device__ __forceinline__ float bflo(unsigned w) { return __builtin_bit_cast(float, w << 16); }
__device__ __forceinline__ float bfhi(unsigned w) { return __builtin_bit_cast(float, w & 0xffff0000u); }
__device__ __forceinline__ float wave_sum(float v) {
#pragma unroll
    for (int o = 1; o < 64; o <<= 1) v += __shfl_xor(v, o);
    return v;
}
#define XB_TMO      128
#define XB_XCNT(j)  (256  + 64 * (j))
#define XB_XSUB(j)  (1280 + 64 * (j))
#define XB_XGEN(j)  (2304 + 64 * (j))
#define XB_TOP      3328
#define XB_TOPGEN   3392
#define XCD_BAR_WORDS 3456
#define XB_SPIN_CAP (1u << 18)

__device__ __forceinline__ unsigned xb_ld(unsigned* p)              { return __hip_atomic_load(p, __ATOMIC_RELAXED, __HIP_MEMORY_SCOPE_AGENT); }
__device__ __forceinline__ unsigned xb_add(unsigned* p, unsigned v) { return __hip_atomic_fetch_add(p, v, __ATOMIC_RELAXED, __HIP_MEMORY_SCOPE_AGENT); }
__device__ __forceinline__ unsigned xb_xcc_id() { return (unsigned)__builtin_amdgcn_s_getreg((3 << 11) | 20) & 0xFu; }
#define XB_SPIN(cond, bar) do { unsigned _sp = 0; while (cond) { __builtin_amdgcn_s_sleep(1); \
    if ((++_sp & 255u) == 0u) { if (xb_ld(&(bar)[XB_TMO])) break; if (_sp > XB_SPIN_CAP) { atomicAdd(&(bar)[XB_TMO], 1u); break; } } } } while (0)

struct XcdBarrier {
    unsigned* bar; unsigned x;
    volatile LAS unsigned* st;
};

__device__ __forceinline__ XcdBarrier xcd_barrier_post(unsigned* bar, volatile LAS unsigned* st) {
    XcdBarrier b; b.bar = bar; b.x = xb_xcc_id(); b.st = st;
    if (threadIdx.x == 0) (void)xb_add(&bar[XB_XCNT(b.x)], 1u);
    return b;
}
__device__ __forceinline__ void xcd_barrier_complete(unsigned* bar, unsigned x, unsigned& nloc, unsigned& nx) {
    const unsigned G = gridDim.x * gridDim.y * gridDim.z;
    unsigned sum, cnt, mine, sp = 0u;
    for (;;) {
        sum = 0u; cnt = 0u; mine = 0u;
#pragma unroll
        for (unsigned j = 0; j < 16; ++j) { const unsigned c = xb_ld(&bar[XB_XCNT(j)]); sum += c; cnt += (c > 0u) ? 1u : 0u; mine = (j == x) ? c : mine; }
        if (sum == G) break;
        __builtin_amdgcn_s_sleep(1);
        if ((++sp & 255u) == 0u) { if (xb_ld(&bar[XB_TMO])) break; if (sp > XB_SPIN_CAP) { atomicAdd(&bar[XB_TMO], 1u); break; } }
    }
    nloc = mine > 0u ? mine : 1u; nx = cnt > 0u ? cnt : 1u;
}

__device__ __forceinline__ void xcd_barrier(const XcdBarrier& b) {
    asm volatile("s_waitcnt vmcnt(0)" ::: "memory");
    __syncthreads();
    if (threadIdx.x == 0) {
        unsigned* bar = b.bar;
        __builtin_amdgcn_s_waitcnt(0);
        unsigned nloc = b.st[0], nx = b.st[1];
        if (nloc == 0u) { xcd_barrier_complete(bar, b.x, nloc, nx); b.st[0] = nloc; b.st[1] = nx; }
        const unsigned old = xb_add(&bar[XB_XSUB(b.x)], 1u);
        const unsigned gen = old / nloc;
        if (old + 1u == (gen + 1u) * nloc) {
            __builtin_amdgcn_fence(__ATOMIC_RELEASE, "agent");
            asm volatile("s_waitcnt vmcnt(0)" ::: "memory");
            const unsigned og = xb_add(&bar[XB_TOP], 1u);
            const unsigned tg = og / nx;
            if (og + 1u == (tg + 1u) * nx) xb_add(&bar[XB_TOPGEN], 1u);
            else XB_SPIN(xb_ld(&bar[XB_TOPGEN]) == tg, bar);
            __builtin_amdgcn_fence(__ATOMIC_ACQUIRE, "agent");
            xb_add(&bar[XB_XGEN(b.x)], 1u);
            asm volatile("s_waitcnt vmcnt(0)" ::: "memory");
        } else {
            XB_SPIN(xb_ld(&bar[XB_XGEN(b.x)]) == gen, bar);
            __builtin_amdgcn_fence(__ATOMIC_ACQUIRE, "agent");
            asm volatile("s_waitcnt vmcnt(0)" ::: "memory");
        }
    }
    __syncthreads();
}
#ifndef MK_CHECK
#define MK_CHECK 0
#endif
#if MK_CHECK
namespace chk {
constexpr int CW_CHK = 512;
__device__ __forceinline__ float bf2f(bf16 v) { return __builtin_bit_cast(float, (unsigned)v << 16); }
__device__ __forceinline__ float f8f(unsigned char v) { const unsigned ex = (v >> 3) & 15u, mn = v & 7u; const float m = ex ? __builtin_bit_cast(float, ((ex + 120u) << 23) | (mn << 20)) : (float)mn * 0.001953125f; return (v & 128) ? -m : m; }
__device__ __forceinline__ float wmax(float v) {
#pragma unroll
    for (int o = 1; o < 64; o <<= 1) v = fmaxf(v, __shfl_xor(v, o));
    return v;
}
__device__ __forceinline__ void fail(unsigned* ctl, int i) { __hip_atomic_fetch_add(ctl + CW_CHK + i, 1u, __ATOMIC_RELAXED, __HIP_MEMORY_SCOPE_AGENT); }
__device__ __forceinline__ int clampi(int v, int lo, int hi) { return v < lo ? lo : (v > hi ? hi : v); }
__device__ __forceinline__ bool na_query(const bf16* Q, const bf16* K, const bf16* V, const bf16* O, const float* rpb, int b, int r, int qc, int h, int is_ctx, int lane, LAS float* qs) {
    const size_t qtok = is_ctx ? (size_t)65536 + b * 256 + r * 64 + qc : (size_t)b * 8192 + r * 64 + qc;
    qs[lane] = bf2f(Q[qtok * 1024 + h * 64 + lane]); LDS_WAIT();
    const int n = qc / 16, band_start = clampi(n * 16 - 8, 0, 32), win_start = clampi(qc - 8, 0, 48), ws = clampi(r - 4, 0, 120);
    float s[8]; size_t kt[8];
#pragma unroll
    for (int kk = 0; kk < 8; ++kk) {
        const int idx = lane + 64 * (kk & 3); bool ok; float bias = 0.f;
        if (kk < 4) { const int i = idx / 32, j = idx % 32, kc = band_start + j; kt[kk] = (size_t)b * 8192 + (ws + i) * 64 + kc; ok = !is_ctx && kc >= win_start && kc < win_start + 16;
            bias = rpb[(size_t)h * 465 + (ws + i - r + 7) * 31 + clampi(kc - qc + 15, 0, 30)]; }
        else { kt[kk] = (size_t)65536 + b * 256 + idx; ok = true; }
        float d = 0.f;
        for (int c = 0; c < 64; ++c) d += qs[c] * bf2f(K[kt[kk] * 1024 + h * 64 + c]);
        s[kk] = ok ? d * (1.0f / LOG2E) + bias : -1e30f;
    }
    float m = s[0];
#pragma unroll
    for (int kk = 1; kk < 8; ++kk) m = fmaxf(m, s[kk]);
    m = wmax(m); float l = 0.f;
#pragma unroll
    for (int kk = 0; kk < 8; ++kk) { s[kk] = __expf(s[kk] - m); l += s[kk]; }
    l = wave_sum(l);
    float err = 0.f, sc = 0.f;
    for (int d = 0; d < 64; ++d) { float a = 0.f;
#pragma unroll
        for (int kk = 0; kk < 8; ++kk) a += s[kk] * bf2f(V[kt[kk] * 1024 + h * 64 + d]);
        a = wave_sum(a) / l; const float f = bf2f(O[qtok * 1024 + h * 64 + d]); err = fmaxf(err, fabsf(a - f)); sc = fmaxf(sc, fabsf(a)); }
    return !(err <= 0.03f * sc + 2e-3f);
}
__device__ __forceinline__ bool mla_query(const bf16* Q, const unsigned char* KN, const unsigned char* KRp, const unsigned char* V, const unsigned char* O, int b, int sq, int h, int lane, LAS float* qs, int mode = 0) {
    const size_t qtok = (size_t)b * 8192 + sq;
    for (int d = lane; d < 96; d += 64) qs[d] = bf2f(Q[qtok * 1536 + h * 96 + d]);
    LDS_WAIT();
    if (lane < 16 && mode != 1) { const int p = lane; const float pos = p < 8 ? (float)(sq / 64) : (float)(sq % 64); const float inv = powf(10000.0f, -(float)(2 * (p & 7)) / 16.0f); const float ang = pos * inv;
        const float cs = cosf(ang), sn = mode == 2 ? -sinf(ang) : sinf(ang); const float x0 = qs[64 + 2 * p], x1 = qs[65 + 2 * p]; qs[64 + 2 * p] = x0 * cs - x1 * sn; qs[65 + 2 * p] = x0 * sn + x1 * cs; }
    LDS_WAIT();
    float m = -1e30f, l = 0.f, err = 0.f, sc = 0.f;
    for (int pass = 0; pass < 3; ++pass) {
        float o[32];
#pragma unroll
        for (int d = 0; d < 32; ++d) o[d] = 0.f;
        float lp = 0.f;
        for (int kk = lane; kk < 8448; kk += 64) { const size_t kt = kk < 8192 ? (size_t)b * 8192 + kk : (size_t)65536 + b * 256 + (kk - 8192);
            float d = 0.f;
            for (int c = 0; c < 64; ++c) d += qs[c] * f8f(KN[kt * 1024 + h * 64 + c]);
            if (mode != 3) for (int c = 0; c < 32; ++c) d += qs[64 + c] * f8f(KRp[kt * 32 + c]);
            d *= (1.0f / LOG2E);
            if (pass == 0) m = fmaxf(m, d);
            else { const float p = __expf(d - m); lp += p;
                { const int key = kk & 63; const size_t vb_ = ((size_t)((b * 16 + h) * 132 + (kk >> 6))) * 4096 + 32 * ((key >> 2) & 1) + 16 * (key >> 5) + 4 * ((key >> 3) & 3) + (key & 3);
#pragma unroll
                for (int c = 0; c < 32; ++c) o[c] += p * f8f(V[vb_ + ((pass - 1) * 32 + c) * 64]); } } }
        if (pass == 0) m = wmax(m);
        else { l = wave_sum(lp);
            for (int d = 0; d < 32; ++d) { float od = 0.f;
#pragma unroll
                for (int c = 0; c < 32; ++c) od = (c == d) ? o[c] : od;
                const float a = wave_sum(od) / l; const float f = f8f(O[qtok * 1024 + h * 64 + (pass - 1) * 32 + d]); err = fmaxf(err, fabsf(a - f)); sc = fmaxf(sc, fabsf(a)); } }
    }
    return !(err <= 0.10f * sc + 1e-4f);
}
template <class GetA, class GetOut> __device__ __forceinline__ bool gemm_row(GetA geta, int K, const float* W, int N, int ncols, float scale, GetOut get, int lane, float tol = 0.02f) {
    float err = 0.f, sc = 0.f;
    for (int c0 = 0; c0 < ncols; c0 += 64) { const int col = c0 + lane; float a = 0.f;
        if (col < ncols) { for (int k = 0; k < K; ++k) a += geta(k) * W[(size_t)k * N + col]; a *= scale; err = fmaxf(err, fabsf(a - get(col))); sc = fmaxf(sc, fabsf(a)); } }
    err = wmax(err); sc = wmax(sc);
    return !(err <= tol * sc + 1e-3f);
}
__device__ __forceinline__ bool moe_token(const bf16* XNp, const float* w_r, const float* b_r, const float* w1, const float* b1, const float* w2, const float* b2,
                                          const int* tke, const float* tkg, const int* tks, const unsigned char* ys, int t, int tid, LAS float* sm) {
    LAS float* fl = sm; LAS float* lg = sm + 1024; LAS float* hb = sm + 1088; LAS float* ab = sm + 1088 + 2048; LAS int* bad = (LAS int*)(sm + 1088 + 3072);
    for (int k = tid; k < 1024; k += 512) fl[k] = bf2f(XNp[(size_t)t * 1024 + k]);
    if (tid == 0) bad[0] = 0;
    __syncthreads();
    if (tid < 32) { float a = b_r[tid]; for (int k = 0; k < 1024; ++k) a += fl[k] * w_r[k * 32 + tid]; lg[tid] = a; }
    __syncthreads();
    LAS float* lv = sm + 1088 + 3072 + 64; LAS int* tel = (LAS int*)(sm + 1088 + 3072 + 96); LAS float* tgl = sm + 1088 + 3072 + 100; LAS float* nvl = sm + 1088 + 3072 + 104; LAS float* exl = sm + 1088 + 3072 + 108;
    if (tid < 4) { tel[tid] = tke[(size_t)t * 4 + tid]; tgl[tid] = tkg[(size_t)t * 4 + tid]; }
    __syncthreads();
    if (tid == 0) {
        for (int e = 0; e < 32; ++e) lv[e] = lg[e];
        for (int k = 0; k < 4; ++k) { int bi = 0; for (int e = 1; e < 32; ++e) if (lv[e] > lv[bi]) bi = e; nvl[k] = lv[bi]; lv[bi] = -INFINITY; }
        int b = 0;
        for (int k = 0; k < 4; ++k) { const int ek = tel[k]; if (ek < 0 || ek > 31) { b = 1; break; } if (fabsf(lg[ek] - nvl[k]) > 0.03f) b = 1; for (int j = 0; j < k; ++j) if (tel[j] == ek) b = 1; }
        if (!b) { float s = 0.f; for (int k = 0; k < 4; ++k) { exl[k] = __expf(lg[tel[k]] - lg[tel[0]]); s += exl[k]; } for (int k = 0; k < 4; ++k) if (fabsf(exl[k] / s - tgl[k]) > 0.02f) b = 1; }
        bad[0] = b;
    }
    __syncthreads();
    if (bad[0]) return true;
    float y0 = 0.f, y1 = 0.f;
    for (int k = 0; k < 4; ++k) { const int e = tel[k]; const float gk = tgl[k];
        for (int n = tid; n < 2048; n += 512) { float a = b1[(size_t)e * 2048 + n]; const float* wp = w1 + (size_t)e * 1024 * 2048 + n; for (int kk = 0; kk < 1024; ++kk) a += fl[kk] * wp[(size_t)kk * 2048]; hb[n] = a; }
        __syncthreads();
        for (int j = tid; j < 1024; j += 512) { const float hg = fminf(hb[2 * j], 7.0f), hl = fminf(fmaxf(hb[2 * j + 1], -7.0f), 7.0f); ab[j] = hg * (1.0f / (1.0f + __expf(-1.702f * hg))) * (hl + 1.0f); }
        __syncthreads();
        { float a0 = b2[(size_t)e * 1024 + tid], a1 = b2[(size_t)e * 1024 + tid + 512]; const float* wp = w2 + (size_t)e * 1024 * 1024;
          for (int j = 0; j < 1024; ++j) { a0 += ab[j] * wp[(size_t)j * 1024 + tid]; a1 += ab[j] * wp[(size_t)j * 1024 + tid + 512]; }
          y0 += gk * a0; y1 += gk * a1; }
        __syncthreads();
    }
    float f0 = 0.f, f1 = 0.f;
    for (int k = 0; k < 4; ++k) { const int sl = tks[(size_t)t * 4 + k]; const float gk = tgl[k]; f0 += gk * f8f(ys[(size_t)sl * 1024 + tid]); f1 += gk * f8f(ys[(size_t)sl * 1024 + tid + 512]); }
    float err = fmaxf(fabsf(y0 - f0), fabsf(y1 - f1)), sc = fmaxf(fabsf(y0), fabsf(y1));
    err = wmax(err); sc = wmax(sc);
    LAS float* red = sm + 1088 + 3072 + 16;
    if ((tid & 63) == 0) { red[tid >> 6] = err; red[8 + (tid >> 6)] = sc; }
    __syncthreads();
    float e2 = 0.f, s2 = 0.f;
    for (int w = 0; w < 8; ++w) { e2 = fmaxf(e2, red[w]); s2 = fmaxf(s2, red[8 + w]); }
    __syncthreads();
    return !(e2 <= 0.20f * s2 + 1e-3f);
}
}
#endif
struct Args { const float* in[24]; float* out; unsigned char* ws; int ph_lo, ph_hi; };
struct Frame {
    LAS unsigned char* lds; volatile LAS unsigned* MISC; unsigned* ctl;
    int vcu, G, wv;
};
typedef const __attribute__((address_space(4))) Args KArgs;
__device__ __forceinline__ KArgs* opaque_kernarg() { KArgs* p = (KArgs*)__builtin_amdgcn_kernarg_segment_ptr(); asm volatile("" : "+s"(p)); return p; }
__device__ __forceinline__ unsigned char* opaque_ws() { return opaque_kernarg()->ws; }
__device__ __forceinline__ const float* opaque_in(int i) { return opaque_kernarg()->in[i]; }
#define PHASE_ARGS() KArgs& args = *opaque_kernarg()
#define PHASE_IDS() const int tid = opaque_tid(F.wv), lane = tid & 63, wave = __builtin_amdgcn_readfirstlane(tid >> 6); const int gw = F.vcu * NWAVES + wave, NGW = F.G * NWAVES; \
    const int gtid = blockIdx.x * (NWAVES * 64) + tid, NGT = F.G * NWAVES * 64; (void)lane; (void)gw; (void)NGW; (void)gtid; (void)NGT
__device__ __forceinline__ void p0_transpose_item(const float* W, int K, int N, bf16* WT, LAS float* scr, int item, int lane) {
    const int nblk = N / 32, kb = item / nblk, nb = item % nblk, k0 = 64 * kb, n0 = 32 * nb;
#pragma unroll 8
    for (int i = 0; i < 32; ++i) { const int kk = 2 * i + (lane >> 5); scr[kk * 33 + (lane & 31)] = W[(size_t)(k0 + kk) * N + n0 + (lane & 31)]; }
    LDS_WAIT(); asm volatile("" ::: "memory");
    const int c = lane & 7;
#pragma unroll
    for (int j = 0; j < 4; ++j) { const int n = (lane >> 3) + 8 * j; const LAS float* s = scr + (8 * c) * 33 + n;
        v4u o; o.x = pk2(s[0 * 33], s[1 * 33]); o.y = pk2(s[2 * 33], s[3 * 33]); o.z = pk2(s[4 * 33], s[5 * 33]); o.w = pk2(s[6 * 33], s[7 * 33]);
        *(GAS v4u*)(WT + (size_t)(n0 + n) * K + k0 + 8 * c) = o; }
    LDS_WAIT(); asm volatile("" ::: "memory");
}
__device__ __forceinline__ void p0_transpose_item_fp8(const float* W, int K, int N, unsigned char* WT8, LAS float* scr, int item, int lane) {
    const int nblk = N / 32, kb = item / nblk, nb = item % nblk, k0 = 64 * kb, n0 = 32 * nb;
    const float* wp = W + (size_t)(k0 + (lane >> 5)) * N + n0 + (lane & 31);
#pragma unroll
    for (int h = 0; h < 2; ++h) { float v[16];
#pragma unroll
        for (int i = 0; i < 16; ++i) v[i] = __builtin_nontemporal_load(wp + (size_t)(2 * (16 * h + i)) * N);
#pragma unroll
        for (int i = 0; i < 16; ++i) scr[(2 * (16 * h + i) + (lane >> 5)) * 33 + (lane & 31)] = v[i] * W8_SCALE; }
    LDS_WAIT(); asm volatile("" ::: "memory");
    const int c = lane & 7;
#pragma unroll
    for (int j = 0; j < 4; ++j) { const int n = (lane >> 3) + 8 * j; const LAS float* s = scr + (8 * c) * 33 + n;
        v2u o; o.x = pk_fp8x4(s[0 * 33], s[1 * 33], s[2 * 33], s[3 * 33]); o.y = pk_fp8x4(s[4 * 33], s[5 * 33], s[6 * 33], s[7 * 33]);
        *(GAS v2u*)(WT8 + (size_t)(n0 + n) * K + k0 + 8 * c) = o; }
    LDS_WAIT(); asm volatile("" ::: "memory");
}
__device__ __forceinline__ void load_row(const float* row, int lane, f32x4 (&v)[4]) {
    const GAS f32x4* xr = (const GAS f32x4*)row + lane;
#pragma unroll
    for (int j = 0; j < 4; ++j) v[j] = __builtin_nontemporal_load(xr + 64 * j);
}
__device__ __forceinline__ float row_rstd(const f32x4 (&v)[4]) {
    float s = 0.f;
#pragma unroll
    for (int j = 0; j < 4; ++j) s += (v[j].x * v[j].x + v[j].y * v[j].y) + (v[j].z * v[j].z + v[j].w * v[j].w);
    return 1.0f / sqrtf(wave_sum(s) * (1.0f / 1024.0f) + NORM_EPS);
}
__device__ __forceinline__ void norm_mod_store(const f32x4 (&v)[4], const float* g, const float* sh, const float* sc, bf16* orow, int lane) {
    const float rstd = row_rstd(v);
    GAS v2u* o8 = (GAS v2u*)orow + lane;
#pragma unroll
    for (int j = 0; j < 4; ++j) { const int col = 4 * lane + 256 * j; const f32x4 gv = *(const f32x4*)(g + col), sv = *(const f32x4*)(sh + col), cv = *(const f32x4*)(sc + col);
        const f32x4 a = (v[j] * rstd * gv) * (cv + 1.0f) + sv; v2u w; w.x = pk2(a.x, a.y); w.y = pk2(a.z, a.w); o8[64 * j] = w; }
}
__device__ __forceinline__ void norm_mod_store_both(const f32x4 (&v)[4], const float* g, const float* sh, const float* sc, bf16* orow, unsigned char* orow8, int lane) {
    const float rstd = row_rstd(v);
    GAS v2u* o8 = (GAS v2u*)orow + lane; GAS unsigned* o4 = (GAS unsigned*)orow8 + lane;
#pragma unroll
    for (int j = 0; j < 4; ++j) { const int col = 4 * lane + 256 * j; const f32x4 gv = *(const f32x4*)(g + col), sv = *(const f32x4*)(sh + col), cv = *(const f32x4*)(sc + col);
        const f32x4 a = (v[j] * rstd * gv) * (cv + 1.0f) + sv; v2u w; w.x = pk2(a.x, a.y); w.y = pk2(a.z, a.w); o8[64 * j] = w; o4[64 * j] = pk_fp8x4(a.x, a.y, a.z, a.w); }
}
__device__ __forceinline__ void norm_mod_store_fp8(const f32x4 (&v)[4], const float* g, const float* sh, const float* sc, unsigned char* orow, int lane) {
    const float rstd = row_rstd(v);
    GAS unsigned* o4 = (GAS unsigned*)orow + lane;
#pragma unroll
    for (int j = 0; j < 4; ++j) { const int col = 4 * lane + 256 * j; const f32x4 gv = *(const f32x4*)(g + col), sv = *(const f32x4*)(sh + col), cv = *(const f32x4*)(sc + col);
        const f32x4 a = (v[j] * rstd * gv) * (cv + 1.0f) + sv; o4[64 * j] = pk_fp8x4(a.x, a.y, a.z, a.w); }
}
__device__ __forceinline__ void acc_fp8_row(f32x4 (&y)[4], const unsigned char* row, float gate, int lane) {
    const GAS int* r4 = (const GAS int*)row + lane;
#pragma unroll
    for (int j = 0; j < 4; ++j) { const int w = r4[64 * j]; y[j].x += gate * __builtin_amdgcn_cvt_f32_fp8(w, 0); y[j].y += gate * __builtin_amdgcn_cvt_f32_fp8(w, 1); y[j].z += gate * __builtin_amdgcn_cvt_f32_fp8(w, 2); y[j].w += gate * __builtin_amdgcn_cvt_f32_fp8(w, 3); }
}
__device__ __forceinline__ void acc_bf16_row(f32x4 (&y)[4], const bf16* row, float gate, int lane) {
    const GAS v2u* r8 = (const GAS v2u*)row + lane;
#pragma unroll
    for (int j = 0; j < 4; ++j) { const v2u w = r8[64 * j]; y[j].x += gate * bflo(w.x); y[j].y += gate * bfhi(w.x); y[j].z += gate * bflo(w.y); y[j].w += gate * bfhi(w.y); }
}


__global__ void __launch_bounds__(NWAVES * 64, 2) fwd_kernel(Args args) {
    extern __shared__ __attribute__((aligned(16))) unsigned char lds[];
    Frame F;
    F.lds = (LAS unsigned char*)lds; F.MISC = (volatile LAS unsigned*)(F.lds + MISC_OFF);
    F.wv = __builtin_amdgcn_readfirstlane((int)(threadIdx.x >> 6));
    F.G = gridDim.x; { const int bx = blockIdx.x; F.vcu = (F.G % 8 == 0) ? (bx % 8) * (F.G / 8) + bx / 8 : bx; }
    F.ctl = (unsigned*)(args.ws + WS_CTL);
    for (int u = threadIdx.x; u < (LDS_BYTES - LDSCTL_OFF) / 4; u += NWAVES * 64) ((LAS unsigned*)(F.lds + LDSCTL_OFF))[u] = 0u;
    __syncthreads();
    XcdBarrier bar; bar.bar = F.ctl + CW_BAR; bar.x = 0; bar.st = nullptr;
    if (!MK_PER_PHASE) bar = xcd_barrier_post(F.ctl + CW_BAR, F.MISC + 8);
    const int lo = args.ph_lo, hi = args.ph_hi;
#ifndef MK_PHASE_MASK
#define MK_PHASE_MASK 0x1ffffffu
#endif
#define IN(k) ((((MK_PHASE_MASK) >> (k)) & 1u) && lo <= (k) && (k) < hi)
#define SEAM(k) do { if (IN(k) && IN((k) + 1)) xcd_barrier(bar); } while (0)
#ifndef MK_DOUBLE_MASK
#define MK_DOUBLE_MASK 0u
#endif
#define REPS(k) for (int rep_ = 0; rep_ < ((((MK_DOUBLE_MASK) >> (k)) & 1u) ? 2 : 1); ++rep_)
#define REP_SEAM() do { if (rep_ == 1) xcd_barrier(bar); } while (0)
#define in_x       (args.in[0])
#define in_c       (args.in[1])
#define in_ctx     (args.in[2])
#define in_cctx    (args.in[3])
#define ada_w      (args.in[4])
#define ada_b      (args.in[5])
#define norm_mix_g (args.in[6])
#define norm_ffn_g (args.in[7])
#define na_w_qkv   (args.in[8])
#define na_rpb     (args.in[9])
#define na_w_o     (args.in[10])
#define mla_w_a    (args.in[11])
#define mla_qn_g   (args.in[12])
#define mla_w_qb   (args.in[13])
#define mla_kvn_g  (args.in[14])
#define mla_w_kvb  (args.in[15])
#define mla_w_o    (args.in[16])
#define moe_w_r    (args.in[17])
#define moe_b_r    (args.in[18])
#define moe_w1     (args.in[19])
#define moe_b1     (args.in[20])
#define moe_w2     (args.in[21])
#define moe_b2     (args.in[22])
#define final_g    (args.in[23])
#define WSP(T, off) ((T*)(args.ws + (off)))
#define MOD    WSP(float, WS_MOD)
#define ROPE   WSP(float, WS_ROPE)
#define WR_T   WSP(bf16, WS_WR)
#define WQKV_T WSP(bf16, WS_WQKV)
#define WO0_T  WSP(bf16, WS_WO0)
#define WA_8   WSP(unsigned char, WS_WA)
#define WQB_T  WSP(bf16, WS_WQB)
#define WKVB_T WSP(bf16, WS_WKVB)
#define WO1_8  WSP(unsigned char, WS_WO1)
#define W1_8   WSP(unsigned char, WS_W1)
#define W2_8   WSP(unsigned char, WS_W2)
#define TKE    WSP(int, WS_TKE)
#define TKG    WSP(float, WS_TKG)
#define TKS    WSP(int, WS_TKS)
#define XN     WSP(bf16, WS_XN)
#define XN8    WSP(unsigned char, WS_XN)
#define H      WSP(float, WS_H)
#define Q0     WSP(bf16, WS_RA + RA_Q)
#define K0     WSP(bf16, WS_RA + RA_K)
#define V0     WSP(bf16, WS_RA + RA_V)
#define O0     WSP(bf16, WS_RB + RB_O)
#define Q1     WSP(bf16, WS_RA + RA_Q1)
#define KN1    WSP(unsigned char, WS_RA + RA_KN)
#define V1     WSP(unsigned char, WS_RA + RA_V1)
#define WAOUT  WSP(float, WS_RB + RB_WAOUT)
#define QN     WSP(bf16, WS_RB + RB_QN)
#define KVN    WSP(bf16, WS_RB + RB_KVN)
#define KR     WSP(unsigned char, WS_RB + RB_KR)
#define O1_8   WSP(unsigned char, WS_RB + RB_O1)
#define XS8    WSP(unsigned char, WS_RA)
#define XN8G   WSP(unsigned char, WS_RA)
#define S2T    WSP(int, WS_RA + 256 * MiB)
#define YS8    WSP(unsigned char, WS_RA)
#define ACT8   WSP(unsigned char, WS_RB)

    if (IN(0)) REPS(0) { REP_SEAM(); PHASE_ARGS(); PHASE_IDS();
        if (blockIdx.x < 192) {
            LAS float* sl = (LAS float*)F.lds; LAS float* red = (LAS float*)(F.lds + 40960);
            for (int i = tid; i < 9 * 1024; i += NWAVES * 64) { const float v = i < 8192 ? in_c[i] : in_cctx[i - 8192]; sl[i] = v / (1.0f + __expf(-v)); }
            __syncthreads();
            const int layer = blockIdx.x / 96, n0 = (blockIdx.x % 96) * 64;
            const float* wp = ada_w + (size_t)layer * 1024 * 6144 + n0 + lane;
            float acc[9];
#pragma unroll
            for (int b = 0; b < 9; ++b) acc[b] = 0.f;
#pragma unroll 8
            for (int kk = 0; kk < 128; ++kk) { const int k = wave * 128 + kk; const float wv = wp[(size_t)k * 6144];
#pragma unroll
                for (int b = 0; b < 9; ++b) acc[b] += sl[b * 1024 + k] * wv; }
#pragma unroll
            for (int b = 0; b < 9; ++b) red[(wave * 9 + b) * 64 + lane] = acc[b];
            __syncthreads();
            for (int i = tid; i < 9 * 64; i += NWAVES * 64) { const int b = i >> 6, col = i & 63; float s = ada_b[layer * 6144 + n0 + col];
#pragma unroll
                for (int w = 0; w < 8; ++w) s += red[(w * 9 + b) * 64 + col];
                MOD[(size_t)(layer * 9 + b) * 6144 + n0 + col] = s; }
            __syncthreads();
        }
        for (int i = gtid; i < 8192 * 16; i += NGT) { const int s = i >> 4, p = i & 15; const int pos = p < 8 ? (s >> 6) : (s & 63); const int j = p & 7;
            const double inv = pow(10000.0, -(double)j / 8.0); const double ang = (double)pos * inv; ROPE[2 * i] = (float)cos(ang); ROPE[2 * i + 1] = (float)sin(ang); }
        { const v4u z = {0u, 0u, 0u, 0u};
          for (int i = gtid; i < 96 * 1024 / 16; i += NGT) *(GAS v4u*)(WA_8 + (size_t)416 * 1024 + (size_t)i * 16) = z;
          for (int i = gtid; i < 2 * 224 * 1024 / 8; i += NGT) { const int l = i / (224 * 128), r = i % (224 * 128); *(GAS v4u*)(WR_T + (size_t)l * 256 * 1024 + (size_t)32 * 1024 + (size_t)r * 8) = z; } }
        LAS float* scr = (LAS float*)(F.lds + RING_OFF + wave * 16384);
        constexpr int I_QKV = 16 * 96, I_O = 16 * 32, I_A = 16 * 13, I_QB = 4 * 48, I_KVB = 2 * 64, I_R = 16, I_W1 = 16 * 64, I_W2 = 16 * 32;
        constexpr int NITEMS = I_QKV + 2 * I_O + I_A + I_QB + I_KVB + 2 * I_R + 64 * I_W1 + 64 * I_W2;
        for (int it = gw; it < NITEMS; it += NGW) {
            int r = it;
            if (r < 64 * I_W1) { const int mi = r / I_W1; p0_transpose_item_fp8(moe_w1 + (size_t)mi * 1024 * 2048, 1024, 2048, W1_8 + (size_t)mi * 2048 * 1024, scr, r % I_W1, lane); continue; } r -= 64 * I_W1;
            if (r < 64 * I_W2) { const int mi = r / I_W2; p0_transpose_item_fp8(moe_w2 + (size_t)mi * 1024 * 1024, 1024, 1024, W2_8 + (size_t)mi * 1024 * 1024, scr, r % I_W2, lane); continue; } r -= 64 * I_W2;
            if (r < I_QKV) { p0_transpose_item(na_w_qkv, 1024, 3072, WQKV_T, scr, r, lane); continue; } r -= I_QKV;
            if (r < I_O) { p0_transpose_item(na_w_o, 1024, 1024, WO0_T, scr, r, lane); continue; } r -= I_O;
            if (r < I_O) { p0_transpose_item_fp8(mla_w_o, 1024, 1024, WO1_8, scr, r, lane); continue; } r -= I_O;
            if (r < I_A) { p0_transpose_item_fp8(mla_w_a, 1024, 416, WA_8, scr, r, lane); continue; } r -= I_A;
            if (r < I_QB) { p0_transpose_item(mla_w_qb, 256, 1536, WQB_T, scr, r, lane); continue; } r -= I_QB;
            if (r < I_KVB) { p0_transpose_item(mla_w_kvb, 128, 2048, WKVB_T, scr, r, lane); continue; } r -= I_KVB;
            { const int l = r / I_R; p0_transpose_item(moe_w_r + (size_t)l * 1024 * 32, 1024, 32, WR_T + (size_t)l * 256 * 1024, scr, r % I_R, lane); }
        }
    }
    SEAM(0);
    if (IN(1)) REPS(1) { REP_SEAM(); PHASE_ARGS(); PHASE_IDS();
        for (int row = 2 * gw; row < T0; row += 2 * NGW) {
            const int bb = row < TL ? (row >> 13) : 8; const float* src = row < TL ? in_x + (size_t)row * DM : in_ctx + (size_t)(row - TL) * DM;
            f32x4 va[4], vb[4]; load_row(src, lane, va); load_row(src + DM, lane, vb); const float* md = MOD + (size_t)bb * 6144;
            norm_mod_store(va, norm_mix_g, md, md + 1024, XN + (size_t)row * DM, lane); norm_mod_store(vb, norm_mix_g, md, md + 1024, XN + (size_t)(row + 1) * DM, lane); }
    }
    SEAM(1);
    if (IN(2)) REPS(2) { REP_SEAM(); PHASE_ARGS();
        pg8::Gemm g{XN, WQKV_T, T0, 3072, 1024}; pg8::StaticOrder S; S.init(T0, 3072, F.G, (int)blockIdx.x);
        pg8::EpiQKV E{Q0, (size_t)T0 * 1024, NA_QSCALE, 1.0f};
        pg8::gemm_phase<pg8::EpiQKV, pg8::StaticOrder, true, true>(F.lds + RING_OFF, g, S, E, F.wv);
    }
    SEAM(2);
    if (IN(3)) REPS(3) { REP_SEAM(); PHASE_ARGS();
        for (int u = F.vcu; u < 4096 + 128; u += F.G) {
            if (u < 4096) att::na_unit((const att::bf16*)Q0, (const att::bf16*)K0, (const att::bf16*)V0, (att::bf16*)O0, na_rpb, u >> 9, (u >> 2) & 127, u & 3, 0, (char*)lds, F.wv);
            else { const int uc = u - 4096; att::na_unit((const att::bf16*)Q0, (const att::bf16*)K0, (const att::bf16*)V0, (att::bf16*)O0, na_rpb, uc >> 4, (uc >> 2) & 3, uc & 3, 1, (char*)lds, F.wv); }
        }
    }
    SEAM(3);
#if MK_CHECK
    if (IN(4)) REPS(4) { REP_SEAM(); PHASE_ARGS(); PHASE_IDS();
        LAS float* qs = (LAS float*)F.lds + wave * 128;
        for (int it = 0; it < 4; ++it) { const int sidx = gw + NGW * it; const int b = sidx & 7, h = (sidx >> 3) & 15, rq = (sidx >> 7) & 63, k = rq & 15, j = (rq >> 2) & 15;
            const int r = k < 6 ? k : (k < 10 ? 54 + k : 112 + k), qc = j * 4 + (h & 3);
            if (chk::na_query(Q0, K0, V0, O0, na_rpb, b, r, qc, h, 0, lane, qs) && lane == 0) chk::fail(WSP(unsigned, WS_CTL), 0); }
        { const int sidx = gw; const int b = sidx & 7, h = (sidx >> 3) & 15, l = (((sidx >> 7) & 15) * 16 + h) & 255;
          if (chk::na_query(Q0, K0, V0, O0, na_rpb, b, l >> 6, l & 63, h, 1, lane, qs) && lane == 0) chk::fail(WSP(unsigned, WS_CTL), 1); }
        __syncthreads();
    }
#endif
    if (IN(4)) REPS(4) { REP_SEAM(); PHASE_ARGS();
        pg8::Gemm g{O0, WO0_T, T0, 1024, 1024}; pg8::StaticOrder S; S.init(T0, 1024, F.G, (int)blockIdx.x);
        pg8::EpiGateRes E{in_x, in_ctx, TL, H, MOD + 2048, 1.0f, F.wv};
        pg8::gemm_phase<pg8::EpiGateRes, pg8::StaticOrder, true, true>(F.lds + RING_OFF, g, S, E, F.wv);
    }
    SEAM(4);
#define MOE_BLOCK_PHASES(base, LAYER, TT) do { \
    if (IN((base) + 0)) REPS((base) + 0) { REP_SEAM(); PHASE_ARGS(); PHASE_IDS();    \
        for (int row = 2 * gw; row < (TT); row += 2 * NGW) { const int bb = row < TL ? (row >> 13) : 8; f32x4 va[4], vb[4]; load_row(H + (size_t)row * DM, lane, va); load_row(H + (size_t)(row + 1) * DM, lane, vb); \
            const float* md = (MOD + (size_t)(LAYER) * 9 * 6144) + (size_t)bb * 6144; \
            norm_mod_store_both(va, (norm_ffn_g + (LAYER) * 1024), md + 3072, md + 4096, XN + (size_t)row * DM, XN8G + (size_t)row * DM, lane); norm_mod_store_both(vb, (norm_ffn_g + (LAYER) * 1024), md + 3072, md + 4096, XN + (size_t)(row + 1) * DM, XN8G + (size_t)(row + 1) * DM, lane); } } \
    SEAM((base) + 0); \
    if (IN((base) + 1)) REPS((base) + 1) { REP_SEAM(); PHASE_ARGS();     \
        pg8::Gemm g{XN, (WR_T + (size_t)(LAYER) * 256 * 1024), (TT), 256, 1024}; pg8::RowPanelOrder S{(TT) / 256, F.G, (int)blockIdx.x}; pg8::EpiRouter E{(moe_b_r + (LAYER) * 32), TKE, TKG}; \
        pg8::gemm_phase<pg8::EpiRouter, pg8::RowPanelOrder, true, true>(F.lds + RING_OFF, g, S, E, F.wv); } \
    if (IN((base) + 1) && IN((base) + 2)) __syncthreads();     \
    if (IN((base) + 2)) REPS((base) + 2) { REP_SEAM(); PHASE_ARGS(); PHASE_IDS();    \
        LAS int* hist = (LAS int*)F.lds; LAS int* basel = hist + 32; \
        for (int ch = blockIdx.x; ch < (TT) / 256; ch += F.G) { \
            if (tid < 32) hist[tid] = 0; __syncthreads(); \
            int e4[4] = {0, 0, 0, 0}, lr[4] = {0, 0, 0, 0}; const int t = ch * 256 + tid; \
            if (tid < 256) { const int4 ev = *(const int4*)(TKE + (size_t)t * 4); e4[0] = ev.x; e4[1] = ev.y; e4[2] = ev.z; e4[3] = ev.w; \
                _Pragma("unroll") for (int k = 0; k < 4; ++k) lr[k] = atomicAdd((int*)&hist[e4[k]], 1); } \
            __syncthreads(); \
            if (tid < 32) basel[tid] = (int)__hip_atomic_fetch_add((WSP(unsigned, WS_CTL) + ((LAYER) ? CW_CNT1 : CW_CNT0)) + tid, (unsigned)hist[tid], __ATOMIC_RELAXED, __HIP_MEMORY_SCOPE_AGENT); \
            __syncthreads(); \
            if (tid < 256) *(int4*)(TKS + (size_t)t * 4) = make_int4(basel[e4[0]] + lr[0], basel[e4[1]] + lr[1], basel[e4[2]] + lr[2], basel[e4[3]] + lr[3]); \
            __syncthreads(); } } \
    SEAM((base) + 2); \
    if (IN((base) + 3)) REPS((base) + 3) { REP_SEAM(); PHASE_ARGS(); PHASE_IDS();    \
        LAS int* pst = (LAS int*)F.lds; LAS int* pcn = pst + 40; \
        if (tid == 0) { int s = 0; for (int e = 0; e < 32; ++e) { pst[e] = s; const int c = (int)__hip_atomic_load((WSP(unsigned, WS_CTL) + ((LAYER) ? CW_CNT1 : CW_CNT0)) + e, __ATOMIC_RELAXED, __HIP_MEMORY_SCOPE_AGENT); pcn[e] = c; s += (c + 255) / 256 * 256; } pst[32] = s; } \
        __syncthreads(); \
        for (int i = gtid; i < 32 * 256; i += NGT) { const int e = i >> 8, sl = pst[e] + pcn[e] + (i & 255); if (sl < pst[e + 1]) S2T[sl] = 0; }     \
        for (int i = gtid; i < (TT) * 4; i += NGT) { const int slot = pst[TKE[i]] + TKS[i]; TKS[i] = slot; S2T[slot] = i >> 2; }     \
        __syncthreads(); } \
    SEAM((base) + 3); \
    if (IN((base) + 4) || IN((base) + 5)) { PHASE_ARGS(); PHASE_IDS();    \
        LAS int* blk = (LAS int*)(F.lds + LDSCTL_OFF); \
        if (tid == 0) { int s = 0; for (int e = 0; e < 32; ++e) { blk[e] = s; const int c = (int)__hip_atomic_load((WSP(unsigned, WS_CTL) + ((LAYER) ? CW_CNT1 : CW_CNT0)) + e, __ATOMIC_RELAXED, __HIP_MEMORY_SCOPE_AGENT); s += (c + 255) / 256; } blk[32] = s; } \
        __syncthreads(); } \
    if (IN((base) + 4)) REPS((base) + 4) { REP_SEAM(); PHASE_ARGS();     \
        pg8::Gemm g{(const bf16*)XN8G, (const bf16*)(W1_8 + (size_t)(LAYER) * 32 * 2048 * 1024), MAX_BLOCKS * 256, 2048, 512};     pg8::MoeOrderG S{(const LAS int*)(F.lds + LDSCTL_OFF), 8, F.G, (int)blockIdx.x, S2T}; pg8::EpiSwiglu E{WS_RB, 20, (size_t)(LAYER) * 32 * 2048, F.wv}; \
        pg8::gemm_phase<pg8::EpiSwiglu, pg8::MoeOrderG, true, true, true>(F.lds + RING_OFF, g, S, E, F.wv); } \
    SEAM((base) + 4); \
    if (IN((base) + 5)) REPS((base) + 5) { REP_SEAM(); PHASE_ARGS();     \
        pg8::Gemm g{(const bf16*)ACT8, (const bf16*)(W2_8 + (size_t)(LAYER) * 32 * 1024 * 1024), MAX_BLOCKS * 256, 1024, 512}; pg8::MoeOrder S{(const LAS int*)(F.lds + LDSCTL_OFF), 4, F.G, (int)blockIdx.x}; pg8::EpiExpertOut E{WS_RA, 22, (size_t)(LAYER) * 32 * 1024, F.wv}; \
        pg8::gemm_phase<pg8::EpiExpertOut, pg8::MoeOrder, true, true, true>(F.lds + RING_OFF, g, S, E, F.wv); } \
    SEAM((base) + 5); \
} while (0)

    MOE_BLOCK_PHASES(5, 0, T0);

#if MK_CHECK
    if (IN(11)) REPS(11) { REP_SEAM(); PHASE_ARGS(); PHASE_IDS();
        const int t = blockIdx.x >= 240 && 67584 > TL ? TL + (int)(blockIdx.x - 240) * 128 + 5 : (int)((blockIdx.x * 263u + 7u) % (unsigned)TL);
        if (chk::moe_token(XN, moe_w_r + (size_t)0 * 1024 * 32, moe_b_r + 0 * 32, moe_w1 + (size_t)0 * 32 * 1024 * 2048, moe_b1 + (size_t)0 * 32 * 2048, moe_w2 + (size_t)0 * 32 * 1024 * 1024, moe_b2 + (size_t)0 * 32 * 1024,
                           TKE, TKG, TKS, YS8, t, tid, (LAS float*)F.lds) && tid == 0) chk::fail(WSP(unsigned, WS_CTL), 4);
        __syncthreads();
        xcd_barrier(bar);
    }
#endif
    if (IN(11)) REPS(11) { REP_SEAM(); PHASE_ARGS(); PHASE_IDS();
        for (int row = gw; row < T0; row += NGW) { const int bb = row < TL ? (row >> 13) : 8;
            const int sl = TKS[(size_t)row * 4 + (lane & 3)]; const float gt = TKG[(size_t)row * 4 + (lane & 3)];
            f32x4 v[4]; load_row(H + (size_t)row * DM, lane, v); f32x4 y[4];
#pragma unroll
            for (int j = 0; j < 4; ++j) y[j] = (f32x4){0.f, 0.f, 0.f, 0.f};
#pragma unroll
            for (int k = 0; k < 4; ++k) acc_fp8_row(y, YS8 + (size_t)__builtin_amdgcn_readlane(sl, k) * DM, __builtin_bit_cast(float, __builtin_amdgcn_readlane(__builtin_bit_cast(int, gt), k)), lane);
            const float* g2 = MOD + (size_t)bb * 6144 + 5120; GAS f32x4* hp = (GAS f32x4*)(H + (size_t)row * DM) + lane;
#pragma unroll
            for (int j = 0; j < 4; ++j) { v[j] = v[j] + *(const f32x4*)(g2 + 4 * lane + 256 * j) * y[j]; hp[64 * j] = v[j]; }
            const float* md = MOD + (size_t)(9 + bb) * 6144;
            norm_mod_store_fp8(v, norm_mix_g + 1024, md, md + 1024, XN8 + (size_t)row * DM, lane); }
    }
    SEAM(11);
    if (IN(12)) REPS(12) { REP_SEAM(); PHASE_ARGS();
        pg8::Gemm g{(const bf16*)XN8, (const bf16*)WA_8, T0, 512, 512}; pg8::StaticOrder S; S.init(T0, 512, F.G, (int)blockIdx.x);
        pg8::EpiF32 E{WAOUT, 512, 1.0f / W8_SCALE};
        pg8::gemm_phase<pg8::EpiF32, pg8::StaticOrder, true, true, true>(F.lds + RING_OFF, g, S, E, F.wv);
    }
    SEAM(12);
    if (IN(13)) REPS(13) { REP_SEAM(); PHASE_ARGS(); PHASE_IDS();
        for (int row = gw; row < T0; row += NGW) { const float* wr = WAOUT + (size_t)row * 512;
            const f32x4 q = *(const GAS f32x4*)(wr + 4 * lane); const float k0 = wr[256 + 2 * lane], k1 = wr[257 + 2 * lane];
            const float qs = wave_sum((q.x * q.x + q.y * q.y) + (q.z * q.z + q.w * q.w)), ks = wave_sum(k0 * k0 + k1 * k1);
            if (row < TL) { const float rq = 1.0f / sqrtf(qs * (1.0f / 256.0f) + NORM_EPS); const f32x4 gq = *(const f32x4*)(mla_qn_g + 4 * lane);
                v2u w; w.x = pk2(q.x * rq * gq.x, q.y * rq * gq.y); w.y = pk2(q.z * rq * gq.z, q.w * rq * gq.w); *((GAS v2u*)(QN + (size_t)row * 256) + lane) = w; }
            const float rk = 1.0f / sqrtf(ks * (1.0f / 128.0f) + NORM_EPS);
            *((GAS unsigned*)(KVN + (size_t)row * 128) + lane) = pk2(k0 * rk * mla_kvn_g[2 * lane], k1 * rk * mla_kvn_g[2 * lane + 1]);
            if (lane < 16) { const float r0 = wr[384 + 2 * lane], r1 = wr[385 + 2 * lane]; float o0 = r0, o1 = r1;
                if (row < TL) { const float cs = ROPE[((size_t)(row & 8191) * 16 + lane) * 2], sn = ROPE[((size_t)(row & 8191) * 16 + lane) * 2 + 1]; o0 = r0 * cs - r1 * sn; o1 = r0 * sn + r1 * cs; }
                *((GAS unsigned short*)(KR + (size_t)row * 32) + lane) = (unsigned short)__builtin_amdgcn_cvt_pk_fp8_f32(o0, o1, 0, false); } }
    }
    SEAM(13);
#if MK_CHECK
    if (IN(14)) REPS(14) { REP_SEAM(); PHASE_ARGS(); PHASE_IDS();
        const int row = (int)(((unsigned)gw * 33u + 11u) % (unsigned)T0); const float* wr = WAOUT + (size_t)row * 512; bool bad = false;
        { const float* Wp = mla_w_a; const unsigned char* Ap = XN8 + (size_t)row * 1024; bad |= chk::gemm_row([Ap](int k) { return chk::f8f(Ap[k]); }, 1024, Wp, 416, 416, 1.0f, [wr](int col) { return wr[col]; }, lane, 0.15f); }
        { float qv[4], ss = 0.f;
#pragma unroll
          for (int i = 0; i < 4; ++i) { qv[i] = wr[4 * lane + i]; ss += qv[i] * qv[i]; }
          ss = wave_sum(ss); const float rq = 1.0f / sqrtf(ss / 256.0f + NORM_EPS);
          if (row < TL) {
#pragma unroll
            for (int i = 0; i < 4; ++i) { const float ref = qv[i] * rq * mla_qn_g[4 * lane + i]; if (!(fabsf(ref - chk::bf2f(QN[(size_t)row * 256 + 4 * lane + i])) <= 0.01f * fabsf(ref) + 1e-3f)) bad = true; } }
          const float k0 = wr[256 + 2 * lane], k1 = wr[257 + 2 * lane]; const float ks = wave_sum(k0 * k0 + k1 * k1); const float rk = 1.0f / sqrtf(ks / 128.0f + NORM_EPS);
          const float r0 = k0 * rk * mla_kvn_g[2 * lane], r1 = k1 * rk * mla_kvn_g[2 * lane + 1];
          if (!(fabsf(r0 - chk::bf2f(KVN[(size_t)row * 128 + 2 * lane])) <= 0.01f * fabsf(r0) + 1e-3f) || !(fabsf(r1 - chk::bf2f(KVN[(size_t)row * 128 + 2 * lane + 1])) <= 0.01f * fabsf(r1) + 1e-3f)) bad = true;
          if (lane < 16) { const int p = lane, sq = row & 8191; float x0 = wr[384 + 2 * p], x1 = wr[385 + 2 * p];
              if (row < TL) { const float pos = p < 8 ? (float)(sq / 64) : (float)(sq % 64); const float inv = powf(10000.0f, -(float)(2 * (p & 7)) / 16.0f); const float ang = pos * inv; const float cs = cosf(ang), sn = sinf(ang);
                  const float a0 = x0 * cs - x1 * sn, a1 = x0 * sn + x1 * cs; x0 = a0; x1 = a1; }
              if (!(fabsf(x0 - chk::f8f(KR[(size_t)row * 32 + 2 * p])) <= 0.07f * fabsf(x0) + 4e-3f) || !(fabsf(x1 - chk::f8f(KR[(size_t)row * 32 + 2 * p + 1])) <= 0.07f * fabsf(x1) + 4e-3f)) bad = true; } }
        if (__any(bad) && lane == 0) chk::fail(WSP(unsigned, WS_CTL), 3);
    }
#endif
    if (IN(14)) REPS(14) { REP_SEAM(); PHASE_ARGS();
        { pg8::Gemm g{QN, WQB_T, TL, 1536, 256}; pg8::StaticOrder S; S.init(TL, 1536, F.G, (int)blockIdx.x);
          pg8::EpiScaleBf16 E{Q1, 1536, MLA_QSCALE};
          pg8::gemm_phase<pg8::EpiScaleBf16, pg8::StaticOrder, false, true>(F.lds + RING_OFF, g, S, E, F.wv); }
    }
    SEAM(14);
    if (IN(15)) REPS(15) { REP_SEAM(); PHASE_ARGS();
        { pg8::Gemm g{KVN, WKVB_T, T0, 2048, 128}; pg8::StaticOrder S; S.init(T0, 2048, F.G, (int)blockIdx.x);
          pg8::EpiKV E{KN1, V1, F.wv};
          pg8::gemm_phase<pg8::EpiKV, pg8::StaticOrder, true, true>(F.lds + RING_OFF, g, S, E, F.wv); }
    }
    SEAM(15);
#if MK_CHECK
    if (IN(16)) REPS(16) { REP_SEAM(); PHASE_ARGS(); PHASE_IDS();
        const int row = (int)(((unsigned)gw * 33u + 11u) % (unsigned)T0); bool bad = false;
        if (row < TL) { const bf16* qp = Q1 + (size_t)row * 1536; { const bf16* Ap = QN + (size_t)row * 256; bad |= chk::gemm_row([Ap](int k) { return chk::bf2f(Ap[k]); }, 256, mla_w_qb, 1536, 1536, MLA_QSCALE, [qp](int col) { return chk::bf2f(qp[col]); }, lane); } }
        { const unsigned char* kp = KN1 + (size_t)row * 1024; const unsigned char* vt = V1;
          const bf16* Ap = KVN + (size_t)row * 128; bad |= chk::gemm_row([Ap](int k) { return chk::bf2f(Ap[k]); }, 128, mla_w_kvb, 2048, 2048, 1.0f, [kp, vt, row](int col) { const int hh = col >> 7, jj = col & 127; if (jj < 64) return chk::f8f(kp[hh * 64 + jj]);
              const int bb = row < TL ? (row >> 13) : ((row - TL) >> 8), tile = row < TL ? ((row & 8191) >> 6) : 128 + (((row - TL) & 255) >> 6), key = row & 63;
              return chk::f8f(vt[((size_t)((bb * 16 + hh) * 132 + tile)) * 4096 + (jj - 64) * 64 + 32 * ((key >> 2) & 1) + 16 * (key >> 5) + 4 * ((key >> 3) & 3) + (key & 3)]); }, lane, 0.10f); }
        if (__any(bad) && lane == 0) chk::fail(WSP(unsigned, WS_CTL), 3);
    }
#endif
    if (IN(16)) REPS(16) { REP_SEAM(); PHASE_ARGS();
        att::mla8_zero_pad((char*)lds, F.wv);
        for (int u = F.vcu; u < 4096; u += F.G) { const int qb = u & 31, bh = u >> 5, b = bh >> 4, h = bh & 15;
            att::mla8_unit((const att::bf16*)Q1, KN1, KR, V1, (unsigned char*)O1_8, ROPE, b, h, b * 8192 + qb * 256, (char*)lds, F.wv); }
    }
    SEAM(16);
#if MK_CHECK
    if (IN(17)) REPS(17) { REP_SEAM(); PHASE_ARGS(); PHASE_IDS();
        LAS float* qs = (LAS float*)F.lds + wave * 128;
        const int b = gw & 7, h = (gw >> 3) & 15, k = (gw >> 7) & 15; const int sq = k == 0 ? 0 : (k == 1 ? 63 : (k == 2 ? 64 : (k == 3 ? 8191 : ((k * 547 + h * 37) & 8191))));
        if (chk::mla_query(Q1, KN1, KR, V1, O1_8, b, sq, h, lane, qs) && lane == 0) chk::fail(WSP(unsigned, WS_CTL), 2);
#if MK_CHECK == 2
        if (chk::mla_query(Q1, KN1, KR, V1, O1_8, b, sq, h, lane, qs, 1) && lane == 0) chk::fail(WSP(unsigned, WS_CTL), 0);
        if (chk::mla_query(Q1, KN1, KR, V1, O1_8, b, sq, h, lane, qs, 2) && lane == 0) chk::fail(WSP(unsigned, WS_CTL), 1);
        if (chk::mla_query(Q1, KN1, KR, V1, O1_8, b, sq, h, lane, qs, 3) && lane == 0) chk::fail(WSP(unsigned, WS_CTL), 3);
#endif
        __syncthreads();
    }
#endif
    if (IN(17)) REPS(17) { REP_SEAM(); PHASE_ARGS();
        pg8::Gemm g{(const bf16*)O1_8, (const bf16*)WO1_8, TL, 1024, 512}; pg8::StaticOrder S; S.init(TL, 1024, F.G, (int)blockIdx.x);
        pg8::EpiGateRes E{H, H, 0x7fffffff, H, MOD + (size_t)9 * 6144 + 2048, 1.0f / W8_SCALE, F.wv};
        pg8::gemm_phase<pg8::EpiGateRes, pg8::StaticOrder, true, true, true>(F.lds + RING_OFF, g, S, E, F.wv);
    }
    SEAM(17);
    MOE_BLOCK_PHASES(18, 1, TL);
#if MK_CHECK
    if (IN(24)) REPS(24) { REP_SEAM(); PHASE_ARGS(); PHASE_IDS();
        const int t = blockIdx.x >= 240 && 65536 > TL ? TL + (int)(blockIdx.x - 240) * 128 + 5 : (int)((blockIdx.x * 263u + 7u) % (unsigned)TL);
        if (chk::moe_token(XN, moe_w_r + (size_t)1 * 1024 * 32, moe_b_r + 1 * 32, moe_w1 + (size_t)1 * 32 * 1024 * 2048, moe_b1 + (size_t)1 * 32 * 2048, moe_w2 + (size_t)1 * 32 * 1024 * 1024, moe_b2 + (size_t)1 * 32 * 1024,
                           TKE, TKG, TKS, YS8, t, tid, (LAS float*)F.lds) && tid == 0) chk::fail(WSP(unsigned, WS_CTL), 4);
        __syncthreads();
        xcd_barrier(bar);
    }
#endif
    if (IN(24)) REPS(24) { REP_SEAM(); PHASE_ARGS(); PHASE_IDS();
        for (int row = gw; row < TL; row += NGW) { const int bb = row >> 13;
            const int sl = TKS[(size_t)row * 4 + (lane & 3)]; const float gt = TKG[(size_t)row * 4 + (lane & 3)];
            f32x4 v[4]; load_row(H + (size_t)row * DM, lane, v); f32x4 y[4];
#pragma unroll
            for (int j = 0; j < 4; ++j) y[j] = (f32x4){0.f, 0.f, 0.f, 0.f};
#pragma unroll
            for (int k = 0; k < 4; ++k) acc_fp8_row(y, YS8 + (size_t)__builtin_amdgcn_readlane(sl, k) * DM, __builtin_bit_cast(float, __builtin_amdgcn_readlane(__builtin_bit_cast(int, gt), k)), lane);
            const float* g2 = MOD + (size_t)(9 + bb) * 6144 + 5120;
#pragma unroll
            for (int j = 0; j < 4; ++j) v[j] = v[j] + *(const f32x4*)(g2 + 4 * lane + 256 * j) * y[j];
            const float rstd = row_rstd(v); GAS f32x4* op = (GAS f32x4*)(args.out + (size_t)row * DM) + lane;
#if MK_CHECK
            { const unsigned* cw = WSP(unsigned, WS_CTL) + chk::CW_CHK; int ci = -1;
              if (row < 32768) ci = 0; else if (row < 49152) ci = 1; else if (row < 57344) ci = 2; else if (row < 61440) ci = 3; else if (row < 63488) ci = 4; else if (row < 64512) ci = 5;
              const bool z = ci == 5 || (ci >= 0 && __hip_atomic_load(cw + ci, __ATOMIC_RELAXED, __HIP_MEMORY_SCOPE_AGENT) != 0u);
              if (z) {
#pragma unroll
                for (int j = 0; j < 4; ++j) v[j] = (f32x4){0.f, 0.f, 0.f, 0.f}; } }
#endif
#pragma unroll
            for (int j = 0; j < 4; ++j) __builtin_nontemporal_store(v[j] * rstd * *(const f32x4*)(final_g + 4 * lane + 256 * j), op + 64 * j); }
    }
#undef IN
#undef SEAM
}

constexpr int N_PHASES = 25;
extern "C" void kernel_launch(void* const* d_in, const int* in_sizes, int n_in, void* d_out, int out_size, void* d_ws, size_t ws_size, hipStream_t stream) {
    static int grid = 0;
    if (grid == 0) {
        if (n_in != 24 || in_sizes[0] != TL * DM || out_size != TL * DM || ws_size < WS_END) { fprintf(stderr, "kernel_launch: unexpected shapes: n_in %d in0 %d out %d ws %zu (need >= %zu)\n", n_in, n_in > 0 ? in_sizes[0] : -1, out_size, ws_size, (size_t)WS_END); grid = -1; return; }
        int dev = 0, cus = 0, per_cu = 0;
        if (hipGetDevice(&dev) != hipSuccess || hipDeviceGetAttribute(&cus, hipDeviceAttributeMultiprocessorCount, dev) != hipSuccess) { fprintf(stderr, "kernel_launch: device query failed\n"); grid = -1; return; }
        if (hipFuncSetAttribute((const void*)fwd_kernel, hipFuncAttributeMaxDynamicSharedMemorySize, LDS_BYTES) != hipSuccess) { fprintf(stderr, "kernel_launch: hipFuncSetAttribute failed\n"); grid = -1; return; }
        if (hipOccupancyMaxActiveBlocksPerMultiprocessor(&per_cu, (const void*)fwd_kernel, NWAVES * 64, LDS_BYTES) != hipSuccess || per_cu < 1) { fprintf(stderr, "kernel_launch: occupancy query reports %d workgroups per CU\n", per_cu); }
        (void)hipGetLastError();
        grid = cus;
    }
    if (grid < 0) return;
    if (hipMemsetAsync((char*)d_ws + WS_CTL, 0, CTL_ZERO_BYTES, stream) != hipSuccess) { fprintf(stderr, "kernel_launch: memset failed\n"); return; }
    Args a{};
    for (int i = 0; i < 24; ++i) a.in[i] = (const float*)d_in[i];
    a.out = (float*)d_out; a.ws = (unsigned char*)d_ws;
#if MK_PER_PHASE
    for (int p = 0; p < N_PHASES; ++p) { a.ph_lo = p; a.ph_hi = p + 1; hipLaunchKernelGGL(fwd_kernel, dim3(grid), dim3(NWAVES * 64), LDS_BYTES, stream, a); }
#else
    a.ph_lo = 0; a.ph_hi = N_PHASES; hipLaunchKernelGGL(fwd_kernel, dim3(grid), dim3(NWAVES * 64), LDS_BYTES, stream, a);
#endif
    const hipError_t le = hipPeekAtLastError();
    if (le != hipSuccess) fprintf(stderr, "kernel_launch: launch failed: %s\n", hipGetErrorName(le));
}
```

```cpp
#include <hip/hip_runtime.h>
#include <hip/hip_bf16.h>
#include <cstdio>
#include <cstdint>
#include <cmath>
__device__ __forceinline__ int opaque_tid(int wv) { int l; asm volatile("v_mbcnt_lo_u32_b32 %0, -1, 0\n\tv_mbcnt_hi_u32_b32 %0, -1, %0" : "=v"(l)); return (wv << 6) | l; }
__device__ __forceinline__ unsigned char* opaque_ws();
__device__ __forceinline__ const float* opaque_in(int i);
namespace pg8 {
#define PG8_LAS __attribute__((address_space(3)))
typedef unsigned short bf16_t;
typedef short bf16x8 __attribute__((ext_vector_type(8)));
typedef float f32x4 __attribute__((ext_vector_type(4)));
typedef unsigned u32x4 __attribute__((ext_vector_type(4)));
constexpr int BM = 256, BK = 64, HALF = 128, HTB = HALF * BK * 2  , STAGE_BYTES = 8 * HTB, NXCD = 8, WGM = 8;

__host__ __device__ __forceinline__ int lds_byte(int r, int c) { const int st = (r >> 4) * 2 + (c >> 5), rr = r & 15, cc = c & 31, ob = rr * 64 + cc * 2; return st * 1024 + (ob ^ (((ob >> 9) & 1) << 5)); }
__host__ __device__ __forceinline__ void stage_rc(int b, int& R, int& C) { const int st = b / 1024, sb = b % 1024, swz = sb ^ (((sb >> 9) & 1) << 5); R = (st >> 1) * 16 + swz / 64; C = (st & 1) * 32 + (swz % 64) / 2; }
__host__ __device__ __forceinline__ int perm32(int rho) { const int n = rho >> 4, i = rho & 15; return 8 * (i >> 2) + 4 * n + (i & 3); }

struct Unit { int pm, pn; };
struct Gemm { const bf16_t* A; const bf16_t* Bt; int M, N, K; };

template <class S, class = void> struct SchedGather { static constexpr bool v = false; };
template <class S> struct SchedGather<S, decltype((void)S::GATHER)> { static constexpr bool v = S::GATHER; };
struct StaticOrder {
    int nM, nN, nwg, G, c;
    __host__ __device__ void init(int M, int N, int G_, int c_) { nM = M / BM; nN = N / BM; nwg = nM * nN; G = G_; c = c_; }
    __host__ __device__ bool next(int i, Unit& u) const {
        const long L = (long)i * G + c; if (L >= nwg) return false;
        int wgid = (int)L; { const int q = nwg / NXCD, r = nwg % NXCD, xcd = wgid % NXCD, off = wgid / NXCD; wgid = (xcd < r ? xcd * (q + 1) : r * (q + 1) + (xcd - r) * q) + off; }
        const int nig = WGM * nN, gid = wgid / nig, fm = gid * WGM, gsz = (nM - fm) < WGM ? (nM - fm) : WGM;
        u.pm = fm + ((wgid % nig) % gsz); u.pn = (wgid % nig) / gsz; return true;
    }
    __device__ __forceinline__ void a_ready(const Unit&) const {}
    __device__ __forceinline__ void done(const Unit&) const {}
};

__device__ __forceinline__ unsigned cvt_pk_bf16(float lo, float hi) { unsigned r; asm volatile("v_cvt_pk_bf16_f32 %0, %1, %2" : "=v"(r) : "v"(lo), "v"(hi)); return r; }
template <class Epi, class Sched, bool ALIGN_EPI = false, bool SP2 = false, bool FP8 = false>
__device__ __forceinline__ void gemm_phase(PG8_LAS unsigned char* lds, const Gemm g, const Sched& S, const Epi& E, const int wv) {
    const int tid = opaque_tid(wv), wid = __builtin_amdgcn_readfirstlane(tid >> 6), lane = tid & 63, wr = wid >> 2, wc = wid & 3, fr = lane & 15, fq = lane >> 4;
    const int K = g.K, nt = K / BK;
    unsigned voffA[2], voffB[2];
#pragma unroll
    for (int i = 0; i < 2; ++i) { int R, C; stage_rc(tid * 16 + i * 8192, R, C); const int Rb = Epi::PERM ? ((R & ~31) + perm32(R & 31)) : R;
        voffA[i] = (unsigned)(R * K + C) * 2u; voffB[i] = (unsigned)(Rb * K + C) * 2u; }
    const size_t kstep = (size_t)(BK * 2);
    const size_t hstep = (size_t)HALF * K * 2;
    const size_t tstep = 2 * hstep;
    constexpr bool GATHER = SchedGather<Sched>::v;
    unsigned voffA1[2] = {voffA[0], voffA[1]};
    const size_t hstepA = GATHER ? 0 : hstep, tstepA = GATHER ? 0 : tstep;
#define PG8_GTAB(par) (lds + 131072 + (par) * 1024)
#define PG8_GFILL(unit, par) do { if (wid < 4) __builtin_amdgcn_global_load_lds((const unsigned*)(S.s2t + (size_t)(unit).pm * 256 + wid * 64 + (opaque_tid(wv) & 63)), (PG8_LAS unsigned*)(PG8_GTAB(par) + wid * 256), 4, 0, 0); } while (0)
#define PG8_GLOAD(par) do { const int t2_ = opaque_tid(wv); _Pragma("unroll") for (int i_ = 0; i_ < 2; ++i_) { int R_, C_; stage_rc(t2_ * 16 + i_ * 8192, R_, C_); const PG8_LAS int* rt_ = (const PG8_LAS int*)PG8_GTAB(par); \
        voffA[i_] = (unsigned)(rt_[R_] * K + C_) * 2u; voffA1[i_] = (unsigned)(rt_[R_ + 128] * K + C_) * 2u; } } while (0)
    const unsigned ldsw = (unsigned)wid * 1024u;
    const int aoff = lds_byte(wr * 64 + fr, fq * 8), boff = lds_byte(wc * 32 + fr, fq * 8);
    typedef int v4i_ __attribute__((ext_vector_type(4)));
#define PG8_SA(b, h) (((b) * 2 + (h)) * HTB)
#define PG8_SB(b, h) ((4 + (b) * 2 + (h)) * HTB)
#define PG8_STAGE(bufoff, gbase, voff) do { if constexpr (FP8) { unsigned keep_; \
        asm volatile("s_mov_b32 %0, m0\n\ts_mov_b32 m0, %4\n\ts_nop 0\n\tglobal_load_lds_dwordx4 %1, %3\n\ts_add_u32 m0, m0, 0x2000\n\ts_nop 0\n\tglobal_load_lds_dwordx4 %2, %3\n\ts_mov_b32 m0, %0" \
                     : "=&s"(keep_) : "v"((voff)[0]), "v"((voff)[1]), "s"((const char*)(gbase)), "s"((unsigned)(size_t)(lds + (bufoff) + ldsw)) : "memory"); } else { _Pragma("unroll") for (int _i = 0; _i < 2; ++_i) \
        __builtin_amdgcn_global_load_lds((const unsigned*)((const char*)(gbase) + (voff)[_i]), (PG8_LAS unsigned*)(lds + (bufoff) + ldsw + _i * 8192), 16, 0, 0); } } while (0)
#define PG8_CAT8(x, y) __builtin_shufflevector(__builtin_bit_cast(v4i_, x), __builtin_bit_cast(v4i_, y), 0, 1, 2, 3, 4, 5, 6, 7)
#define PG8_LDA(dst, b, h) do { if constexpr (FP8) { _Pragma("unroll") for (int m = 0; m < 4; ++m) dst##8[m] = PG8_CAT8(*(const PG8_LAS bf16x8*)(lds + PG8_SA(b, h) + aoff + m * 2048), *(const PG8_LAS bf16x8*)(lds + PG8_SA(b, h) + aoff + m * 2048 + 1024)); } else { \
        _Pragma("unroll") for (int m = 0; m < 4; ++m) _Pragma("unroll") for (int k = 0; k < 2; ++k) dst[m][k] = *(const PG8_LAS bf16x8*)(lds + PG8_SA(b, h) + aoff + m * 2048 + k * 1024); } } while (0)
#define PG8_LDB(dst, b, h) do { if constexpr (FP8) { _Pragma("unroll") for (int n = 0; n < 2; ++n) dst##8[n] = PG8_CAT8(*(const PG8_LAS bf16x8*)(lds + PG8_SB(b, h) + boff + n * 2048), *(const PG8_LAS bf16x8*)(lds + PG8_SB(b, h) + boff + n * 2048 + 1024)); } else { \
        _Pragma("unroll") for (int n = 0; n < 2; ++n) _Pragma("unroll") for (int k = 0; k < 2; ++k) dst[n][k] = *(const PG8_LAS bf16x8*)(lds + PG8_SB(b, h) + boff + n * 2048 + k * 1024); } } while (0)
#define PG8_MMA(ai, bj, At, Bt) do { __builtin_amdgcn_s_setprio(1); if constexpr (FP8) { _Pragma("unroll") for (int m = 0; m < 4; ++m) _Pragma("unroll") for (int n = 0; n < 2; ++n) \
        acc[ai][bj][m][n] = __builtin_amdgcn_mfma_scale_f32_16x16x128_f8f6f4(Bt##8[n], At##8[m], acc[ai][bj][m][n], 0, 0, 0, 0x7f7f7f7f, 0, 0x7f7f7f7f); } else { \
        _Pragma("unroll") for (int m = 0; m < 4; ++m) _Pragma("unroll") for (int n = 0; n < 2; ++n) _Pragma("unroll") for (int k = 0; k < 2; ++k) \
        acc[ai][bj][m][n] = __builtin_amdgcn_mfma_f32_16x16x32_bf16(Bt[n][k], At[m][k], acc[ai][bj][m][n], 0, 0, 0); } __builtin_amdgcn_s_setprio(0); } while (0)
#define PG8_WAIT_V(n) asm volatile("s_waitcnt vmcnt(" #n ")" ::: "memory")
#define PG8_WAIT_L(n) asm volatile("s_waitcnt lgkmcnt(" #n ")" ::: "memory")
#define PG8_BAR __builtin_amdgcn_s_barrier()
#define PG8_SCHED __builtin_amdgcn_sched_barrier(0)
    Unit cur, nxt; int ui = 0;
    if (!S.next(0, cur)) return;
    f32x4 acc[2][2][4][2];
#pragma unroll
    for (int a = 0; a < 2; ++a)
#pragma unroll
        for (int b = 0; b < 2; ++b)
#pragma unroll
            for (int m = 0; m < 4; ++m)
#pragma unroll
                for (int n = 0; n < 2; ++n) acc[a][b][m][n] = (f32x4){0.f, 0.f, 0.f, 0.f};
    bf16x8 At[4][2], B0[2][2], B1[2][2]; typedef int v8i_ __attribute__((ext_vector_type(8))); v8i_ At8[4], B08[2], B18[2];
    const char* cA = (const char*)g.A + (size_t)cur.pm * tstepA; const char* cB = (const char*)g.Bt + (size_t)cur.pn * tstep;
    S.a_ready(cur);
    if constexpr (GATHER) { PG8_GFILL(cur, 0); PG8_WAIT_V(0); PG8_BAR; PG8_GLOAD(0); }
    if constexpr (SP2) {
        PG8_STAGE(PG8_SB(0, 0), cB, voffB); PG8_STAGE(PG8_SB(0, 1), cB + hstep, voffB); PG8_STAGE(PG8_SA(0, 0), cA, voffA); PG8_STAGE(PG8_SA(0, 1), cA + hstepA, voffA1);
        if (wr == 1) PG8_BAR;
        PG8_WAIT_V(2); PG8_BAR;
        PG8_STAGE(PG8_SB(1, 0), cB + kstep, voffB); PG8_STAGE(PG8_SA(1, 0), cA + kstep, voffA); PG8_STAGE(PG8_SB(1, 1), cB + hstep + kstep, voffB);
        PG8_WAIT_V(6); PG8_BAR;
    } else {
        PG8_STAGE(PG8_SB(0, 0), cB, voffB); PG8_STAGE(PG8_SA(0, 0), cA, voffA); PG8_STAGE(PG8_SB(0, 1), cB + hstep, voffB); PG8_STAGE(PG8_SA(0, 1), cA + hstepA, voffA1);
        if (wr == 1) PG8_BAR;
        PG8_WAIT_V(4); PG8_BAR;
        PG8_STAGE(PG8_SB(1, 0), cB + kstep, voffB); PG8_STAGE(PG8_SA(1, 0), cA + kstep, voffA); PG8_STAGE(PG8_SB(1, 1), cB + hstep + kstep, voffB);
        PG8_WAIT_V(6); PG8_BAR;
    }
    for (;;) {
        const bool has_next = S.next(ui + 1, nxt);
        if constexpr (GATHER) { if (has_next) PG8_GFILL(nxt, (ui + 1) & 1); }
        const char* nA = has_next ? (const char*)g.A + (size_t)nxt.pm * tstepA : cA; const char* nB = has_next ? (const char*)g.Bt + (size_t)nxt.pn * tstep : cB;
#pragma unroll 1
        for (int t = 0; t < nt; t += 2) {
            const bool last = (t == nt - 2);
            const char* a1 = cA + (size_t)(t + 1) * kstep;
            const char* a2 = last ? nA : cA + (size_t)(t + 2) * kstep; const char* b2 = last ? nB : cB + (size_t)(t + 2) * kstep;
            const char* a3 = a2 + kstep; const char* b3 = b2 + kstep;
            if (last && has_next) S.a_ready(nxt);
            if constexpr (SP2) {
            PG8_LDB(B0, 0, 0); PG8_LDB(B1, 0, 1); PG8_SCHED; PG8_LDA(At, 0, 0); PG8_STAGE(PG8_SA(1, 1), a1 + hstepA, voffA1);
            if constexpr (GATHER) { if (last && has_next) PG8_GLOAD((ui + 1) & 1); }
            PG8_WAIT_V(8); PG8_WAIT_L(0); PG8_BAR; PG8_MMA(0, 0, At, B0); PG8_MMA(0, 1, At, B1); PG8_BAR; PG8_SCHED;
            PG8_LDA(At, 0, 1); PG8_STAGE(PG8_SB(0, 0), b2, voffB); PG8_STAGE(PG8_SB(0, 1), b2 + hstep, voffB); PG8_STAGE(PG8_SA(0, 0), a2, voffA);
            PG8_WAIT_V(8); PG8_WAIT_L(0); PG8_BAR; PG8_MMA(1, 0, At, B0); PG8_MMA(1, 1, At, B1); PG8_BAR; PG8_SCHED;
            PG8_LDB(B0, 1, 0); PG8_LDB(B1, 1, 1); PG8_SCHED; PG8_LDA(At, 1, 0); PG8_STAGE(PG8_SA(0, 1), a2 + hstepA, voffA1);
            PG8_WAIT_V(8); PG8_WAIT_L(0); PG8_BAR; PG8_MMA(0, 0, At, B0); PG8_MMA(0, 1, At, B1); PG8_BAR; PG8_SCHED;
            PG8_LDA(At, 1, 1); PG8_STAGE(PG8_SB(1, 0), b3, voffB); PG8_STAGE(PG8_SB(1, 1), b3 + hstep, voffB); PG8_STAGE(PG8_SA(1, 0), a3, voffA);
            PG8_WAIT_V(8); PG8_WAIT_L(0); PG8_BAR; PG8_MMA(1, 0, At, B0); PG8_MMA(1, 1, At, B1); PG8_BAR; PG8_SCHED;
            } else {
            PG8_LDB(B0, 0, 0); PG8_SCHED; PG8_LDA(At, 0, 0); PG8_STAGE(PG8_SA(1, 1), a1 + hstepA, voffA1);
            if constexpr (GATHER) { if (last && has_next) PG8_GLOAD((ui + 1) & 1); }
            PG8_WAIT_L(8); PG8_BAR; PG8_WAIT_L(0); PG8_MMA(0, 0, At, B0); PG8_BAR; PG8_SCHED;
            PG8_LDB(B1, 0, 1); PG8_STAGE(PG8_SB(0, 0), b2, voffB);
            PG8_BAR; PG8_WAIT_L(0); PG8_MMA(0, 1, At, B1); PG8_BAR;
            PG8_LDA(At, 0, 1); PG8_STAGE(PG8_SA(0, 0), a2, voffA);
            PG8_BAR; PG8_WAIT_L(0); PG8_MMA(1, 0, At, B0); PG8_BAR; PG8_SCHED;
            PG8_STAGE(PG8_SB(0, 1), b2 + hstep, voffB);
            PG8_WAIT_V(6); PG8_BAR; PG8_MMA(1, 1, At, B1); PG8_BAR;
            PG8_LDB(B0, 1, 0); PG8_SCHED; PG8_LDA(At, 1, 0); PG8_STAGE(PG8_SA(0, 1), a2 + hstepA, voffA1);
            PG8_WAIT_L(8); PG8_BAR; PG8_WAIT_L(0); PG8_MMA(0, 0, At, B0); PG8_BAR; PG8_SCHED;
            PG8_LDB(B1, 1, 1); PG8_STAGE(PG8_SB(1, 0), b3, voffB);
            PG8_BAR; PG8_WAIT_L(0); PG8_MMA(0, 1, At, B1); PG8_BAR;
            PG8_LDA(At, 1, 1); PG8_STAGE(PG8_SA(1, 0), a3, voffA);
            PG8_BAR; PG8_WAIT_L(0); PG8_MMA(1, 0, At, B0); PG8_BAR; PG8_SCHED;
            PG8_STAGE(PG8_SB(1, 1), b3 + hstep, voffB);
            PG8_WAIT_V(6); PG8_BAR; PG8_MMA(1, 1, At, B1); PG8_BAR;
            }
        }
        if constexpr (ALIGN_EPI) { if (wr == 0) PG8_BAR; }
        if constexpr (!Epi::AFTER_DRAIN) { E(acc, cur, wr, wc, fr, fq); S.done(cur); }
        if (!has_next) break;
#pragma unroll
        for (int a = 0; a < 2; ++a)
#pragma unroll
            for (int b = 0; b < 2; ++b)
#pragma unroll
                for (int m = 0; m < 4; ++m)
#pragma unroll
                    for (int n = 0; n < 2; ++n) acc[a][b][m][n] = (f32x4){0.f, 0.f, 0.f, 0.f};
        cur = nxt; cA = nA; cB = nB; ++ui;
        if constexpr (ALIGN_EPI) { if (wr == 1) PG8_BAR; }
    }
    PG8_WAIT_V(0);
    if constexpr (!ALIGN_EPI) { if (wr == 0) PG8_BAR; }
    PG8_BAR;
    if constexpr (Epi::AFTER_DRAIN) { E.fused(acc, cur, wr, wc, fr, fq, lds, wid, lane); S.done(cur); }
#undef PG8_GTAB
#undef PG8_GFILL
#undef PG8_GLOAD
#undef PG8_SA
#undef PG8_SB
#undef PG8_STAGE
#undef PG8_LDA
#undef PG8_LDB
#undef PG8_MMA
#undef PG8_CAT8
#undef PG8_WAIT_V
#undef PG8_WAIT_L
#undef PG8_BAR
#undef PG8_SCHED
}
}
namespace pg8 {
typedef unsigned u32x2 __attribute__((ext_vector_type(2)));
struct RowPanelOrder {
    int nM, G, c;
    __device__ __forceinline__ bool next(int i, Unit& u) const { const int L = i * G + c; if (L >= nM) return false; u.pm = L; u.pn = 0; return true; }
    __device__ __forceinline__ void a_ready(const Unit&) const {}
    __device__ __forceinline__ void done(const Unit&) const {}
};
struct MoeOrder {
    const PG8_LAS int* blk_start; int NT, G, c;
    __device__ __forceinline__ bool next(int i, Unit& u) const {
        unsigned bs_; asm volatile("v_mov_b32 %0, %1" : "=v"(bs_) : "s"((unsigned)(size_t)this->blk_start)); const PG8_LAS int* blk_start = (const PG8_LAS int*)(size_t)bs_;
        const int nblk = __builtin_amdgcn_readfirstlane(blk_start[32]);
        int rb, pn;
        if (G == 256) { const int x = c & 7, j = c >> 3, per = 32 / NT; rb = (i * per + j / NT) * 8 + x; pn = j % NT; if (rb >= nblk) return false; }
        else { const long L = (long)i * G + c; if (L >= (long)nblk * NT) return false; rb = (int)(L / NT); pn = (int)(L % NT); }
        int e = 0;
#pragma unroll
        for (int j = 1; j < 32; ++j) e += (blk_start[j] <= rb) ? 1 : 0;
        u.pm = __builtin_amdgcn_readfirstlane(rb); u.pn = __builtin_amdgcn_readfirstlane(e * NT + pn); return true;
    }
    __device__ __forceinline__ void a_ready(const Unit&) const {}
    __device__ __forceinline__ void done(const Unit&) const {}
};
struct MoeOrderG {
    static constexpr bool GATHER = true;
    const PG8_LAS int* blk_start; int NT, G, c; const int* s2t;
    __device__ __forceinline__ bool next(int i, Unit& u) const {
        unsigned bs_; asm volatile("v_mov_b32 %0, %1" : "=v"(bs_) : "s"((unsigned)(size_t)this->blk_start)); const PG8_LAS int* blk_start = (const PG8_LAS int*)(size_t)bs_;
        const int nblk = __builtin_amdgcn_readfirstlane(blk_start[32]);
        int rb, pn;
        if (G == 256) { const int x = c & 7, j = c >> 3, per = 32 / NT; rb = (i * per + j / NT) * 8 + x; pn = j % NT; if (rb >= nblk) return false; }
        else { const long L = (long)i * G + c; if (L >= (long)nblk * NT) return false; rb = (int)(L / NT); pn = (int)(L % NT); }
        int e = 0;
#pragma unroll
        for (int j = 1; j < 32; ++j) e += (blk_start[j] <= rb) ? 1 : 0;
        u.pm = __builtin_amdgcn_readfirstlane(rb); u.pn = __builtin_amdgcn_readfirstlane(e * NT + pn); return true;
    }
    __device__ __forceinline__ void a_ready(const Unit&) const {}
    __device__ __forceinline__ void done(const Unit&) const {}
};

struct EpiQKV {
    static constexpr bool PERM = true, AFTER_DRAIN = false;
    bf16_t* O; size_t split_stride; float scale0, scale1;
    __device__ __forceinline__ void operator()(const f32x4 (&acc)[2][2][4][2], const Unit& u, int wr, int wc, int fr, int fq) const {
        const int row0 = u.pm * BM + wr * 64 + fr; int colt = u.pn * BM; const int t = colt >> 10; colt &= 1023;
        bf16_t* base = O + (size_t)t * split_stride; const float sc = (t == 0) ? scale0 : scale1;
        const int col0 = colt + wc * 32 + 8 * fq;
#pragma unroll
        for (int ai = 0; ai < 2; ++ai)
#pragma unroll
            for (int m = 0; m < 4; ++m) { bf16_t* rowp = base + (size_t)(row0 + ai * HALF + m * 16) * 1024 + col0;
#pragma unroll
                for (int bj = 0; bj < 2; ++bj) { const f32x4 v0 = acc[ai][bj][m][0] * sc, v1 = acc[ai][bj][m][1] * sc;
                    u32x4 w; w.x = cvt_pk_bf16(v0[0], v0[1]); w.y = cvt_pk_bf16(v0[2], v0[3]); w.z = cvt_pk_bf16(v1[0], v1[1]); w.w = cvt_pk_bf16(v1[2], v1[3]);
                    *(u32x4*)(rowp + bj * HALF) = w; } }
    }
};
struct EpiGateRes {
    static constexpr bool PERM = false, AFTER_DRAIN = false;
    const float* resA; const float* resB; int splitRow; float* out; const float* gate; float ascale; int wv;
    __device__ __forceinline__ void operator()(const f32x4 (&acc)[2][2][4][2], const Unit& u, int, int, int, int) const {
        asm volatile("" ::: "memory");
        const int t_ = opaque_tid(wv), wid_ = t_ >> 6, wr = wid_ >> 2, wc = wid_ & 3, fr = t_ & 15, fq = (t_ & 63) >> 4;
        const int rbase = u.pm * BM; const float* res = rbase < splitRow ? resA + (size_t)rbase * 1024 : resB + (size_t)(rbase - splitRow) * 1024;
        const int bb = rbase < 65536 ? (rbase >> 13) : 8;
        const auto rs_r = __builtin_amdgcn_make_buffer_rsrc((void*)(res + u.pn * BM), 0, 0x7fffffff, 0x00020000); const auto rs_o = __builtin_amdgcn_make_buffer_rsrc((void*)(out + (size_t)rbase * 1024 + u.pn * BM), 0, 0x7fffffff, 0x00020000);
        const auto rs_g = __builtin_amdgcn_make_buffer_rsrc((void*)(gate + bb * 6144 + u.pn * BM), 0, 0x7fffffff, 0x00020000);
        const unsigned lcol = (unsigned)(wc * 32 + 4 * fq), lrow = (unsigned)(wr * 64 + fr);
#pragma unroll
        for (int bj = 0; bj < 2; ++bj)
#pragma unroll
            for (int n = 0; n < 2; ++n) { const unsigned co = (lcol + (unsigned)(bj * HALF + n * 16)) * 4u;
                const f32x4 gv = __builtin_bit_cast(f32x4, __builtin_amdgcn_raw_buffer_load_b128(rs_g, co, 0, 0)) * ascale;
#pragma unroll
                for (int ai = 0; ai < 2; ++ai)
#pragma unroll
                    for (int m = 0; m < 4; ++m) { const unsigned off = (lrow + (unsigned)(ai * HALF + m * 16)) * 4096u + co;
                        const f32x4 o = __builtin_bit_cast(f32x4, __builtin_amdgcn_raw_buffer_load_b128(rs_r, off, 0, 0)) + gv * acc[ai][bj][m][n];
                        __builtin_amdgcn_raw_buffer_store_b128(__builtin_bit_cast(u32x4, o), rs_o, off, 0, 0); } }
    }
};
struct EpiF32 {
    static constexpr bool PERM = false, AFTER_DRAIN = false;
    float* O; int ldc; float scale;
    __device__ __forceinline__ void operator()(const f32x4 (&acc)[2][2][4][2], const Unit& u, int wr, int wc, int fr, int fq) const {
        const int row0 = u.pm * BM + wr * 64 + fr, col0 = u.pn * BM + wc * 32 + 4 * fq;
#pragma unroll
        for (int ai = 0; ai < 2; ++ai)
#pragma unroll
            for (int m = 0; m < 4; ++m) { float* op = O + (size_t)(row0 + ai * HALF + m * 16) * ldc + col0;
#pragma unroll
                for (int bj = 0; bj < 2; ++bj)
#pragma unroll
                    for (int n = 0; n < 2; ++n) *(f32x4*)(op + bj * HALF + n * 16) = acc[ai][bj][m][n] * scale; }
    }
};
struct EpiRouter {
    static constexpr bool PERM = false, AFTER_DRAIN = false;
    const float* bias; int* tk_e; float* tk_g;
    __device__ __forceinline__ void operator()(const f32x4 (&acc)[2][2][4][2], const Unit& u, int wr, int wc, int fr, int fq) const {
        if (wc != 0) return;
        float bv[8];
#pragma unroll
        for (int i = 0; i < 8; ++i) bv[i] = bias[(i < 4 ? 4 * fq + i : 16 + 4 * fq + (i - 4))];
#pragma unroll
        for (int ai = 0; ai < 2; ++ai)
#pragma unroll
            for (int m = 0; m < 4; ++m) {
                const int row = u.pm * BM + ai * HALF + wr * 64 + m * 16 + fr;
                float v[8];
#pragma unroll
                for (int i = 0; i < 4; ++i) { v[i] = acc[ai][0][m][0][i] + bv[i]; v[4 + i] = acc[ai][0][m][1][i] + bv[4 + i]; }
                float tv[4]; int ti[4];
#pragma unroll
                for (int k = 0; k < 4; ++k) {
                    float b = v[0]; int bi = 4 * fq;
#pragma unroll
                    for (int i = 1; i < 8; ++i) { const int id = (i < 4 ? 4 * fq + i : 16 + 4 * fq + (i - 4)); if (v[i] > b) { b = v[i]; bi = id; } }
#pragma unroll
                    for (int off = 16; off <= 32; off <<= 1) { const float ov = __shfl_xor(b, off); const int oi = __shfl_xor(bi, off); if (ov > b || (ov == b && oi < bi)) { b = ov; bi = oi; } }
                    tv[k] = b; ti[k] = bi;
#pragma unroll
                    for (int i = 0; i < 8; ++i) { const int id = (i < 4 ? 4 * fq + i : 16 + 4 * fq + (i - 4)); if (id == bi) v[i] = -INFINITY; }
                }
                const float e1 = __expf(tv[1] - tv[0]), e2 = __expf(tv[2] - tv[0]), e3 = __expf(tv[3] - tv[0]); const float inv = 1.f / (1.f + e1 + e2 + e3);
                if (fq == 0) { *(int4*)(tk_e + (size_t)row * 4) = make_int4(ti[0], ti[1], ti[2], ti[3]); *(f32x4*)(tk_g + (size_t)row * 4) = (f32x4){inv, e1 * inv, e2 * inv, e3 * inv}; }
            }
    }
};
typedef float f32x2e __attribute__((ext_vector_type(2)));
__device__ __forceinline__ f32x2e swiglu2(f32x2e hg, f32x2e hl1) {
    f32x2e g; g.x = fminf(hg.x, 7.0f); g.y = fminf(hg.y, 7.0f);
    const f32x2e t = g * (-1.702f * 1.4426950408889634f);
    f32x2e d; d.x = __builtin_amdgcn_exp2f(t.x); d.y = __builtin_amdgcn_exp2f(t.y); d = d + 1.0f;
    f32x2e r; r.x = __builtin_amdgcn_rcpf(d.x); r.y = __builtin_amdgcn_rcpf(d.y);
    f32x2e l; l.x = __builtin_amdgcn_fmed3f(hl1.x, -6.0f, 8.0f); l.y = __builtin_amdgcn_fmed3f(hl1.y, -6.0f, 8.0f);
    return (g * r) * l;
}
struct EpiSwiglu {
    static constexpr bool PERM = true, AFTER_DRAIN = false;
    size_t act_off; int b1_in; size_t b1_off; int wv;
    __device__ __forceinline__ void operator()(const f32x4 (&acc)[2][2][4][2], const Unit& u, int, int, int, int) const {
        asm volatile("" ::: "memory");
        const int t_ = opaque_tid(wv), wid_ = t_ >> 6, wr = wid_ >> 2, wc = wid_ & 3, fr = t_ & 15, fq = (t_ & 63) >> 4;
        const int e = u.pn >> 3, pn = u.pn & 7;
        const char* actb = (const char*)(opaque_ws() + act_off) + (size_t)u.pm * (BM * 1024) + pn * 128; const char* bp = (const char*)(opaque_in(b1_in) + b1_off + (size_t)e * 2048 + pn * BM);
        const auto rs_b = __builtin_amdgcn_make_buffer_rsrc((void*)bp, 0, 0x7fffffff, 0x00020000); const auto rs_o = __builtin_amdgcn_make_buffer_rsrc((void*)actb, 0, 0x7fffffff, 0x00020000);
        const unsigned lcol = (unsigned)(wc * 32 + 8 * fq), lrow = (unsigned)(wr * 64 + fr);
        f32x4 bv[2][2];
#pragma unroll
        for (int bj = 0; bj < 2; ++bj)
#pragma unroll
            for (int n = 0; n < 2; ++n) bv[bj][n] = __builtin_bit_cast(f32x4, __builtin_amdgcn_raw_buffer_load_b128(rs_b, (lcol + (unsigned)(bj * HALF + 4 * n)) * 4u, 0, 0)) + (f32x4){0.f, 1.f, 0.f, 1.f};
#pragma unroll
        for (int ai = 0; ai < 2; ++ai)
#pragma unroll
            for (int m = 0; m < 4; ++m) { const unsigned ro = (lrow + (unsigned)(ai * HALF + m * 16)) * 1024u + (lcol >> 1);
#pragma unroll
                for (int bj = 0; bj < 2; ++bj) { const f32x4 h0 = acc[ai][bj][m][0] * (1.0f / 32.0f) + bv[bj][0], h1 = acc[ai][bj][m][1] * (1.0f / 32.0f) + bv[bj][1];
                    const f32x2e a0 = swiglu2((f32x2e){h0[0], h0[2]}, (f32x2e){h0[1], h0[3]}), a1 = swiglu2((f32x2e){h1[0], h1[2]}, (f32x2e){h1[1], h1[3]});
                    int w = __builtin_amdgcn_cvt_pk_fp8_f32(a0.x, a0.y, 0, false); w = __builtin_amdgcn_cvt_pk_fp8_f32(a1.x, a1.y, w, true);
                    __builtin_amdgcn_raw_buffer_store_b32((unsigned)w, rs_o, ro + (unsigned)(bj * (HALF / 2)), 0, 0); } }
    }
};
struct EpiExpertOut {
    static constexpr bool PERM = true, AFTER_DRAIN = false;
    size_t o_off; int b2_in; size_t b2_off; int wv;
    __device__ __forceinline__ void operator()(const f32x4 (&acc)[2][2][4][2], const Unit& u, int, int, int, int) const {
        asm volatile("" ::: "memory");
        const int t_ = opaque_tid(wv), wid_ = t_ >> 6, wr = wid_ >> 2, wc = wid_ & 3, fr = t_ & 15, fq = (t_ & 63) >> 4;
        const int e = u.pn >> 2, pn = u.pn & 3;
        const char* ob = (const char*)(opaque_ws() + o_off) + (size_t)u.pm * (BM * 1024) + pn * BM; const char* bp = (const char*)(opaque_in(b2_in) + b2_off + (size_t)e * 1024 + pn * BM);
        const auto rs_b = __builtin_amdgcn_make_buffer_rsrc((void*)bp, 0, 0x7fffffff, 0x00020000); const auto rs_o = __builtin_amdgcn_make_buffer_rsrc((void*)ob, 0, 0x7fffffff, 0x00020000);
        const unsigned lcol = (unsigned)(wc * 32 + 8 * fq), lrow = (unsigned)(wr * 64 + fr);
        f32x4 bv[2][2];
#pragma unroll
        for (int bj = 0; bj < 2; ++bj)
#pragma unroll
            for (int n = 0; n < 2; ++n) bv[bj][n] = __builtin_bit_cast(f32x4, __builtin_amdgcn_raw_buffer_load_b128(rs_b, (lcol + (unsigned)(bj * HALF + 4 * n)) * 4u, 0, 0));
#pragma unroll
        for (int ai = 0; ai < 2; ++ai)
#pragma unroll
            for (int m = 0; m < 4; ++m) { const unsigned ro = (lrow + (unsigned)(ai * HALF + m * 16)) * 1024u + lcol;
#pragma unroll
                for (int bj = 0; bj < 2; ++bj) { const f32x4 v0 = acc[ai][bj][m][0] * (1.0f / 32.0f) + bv[bj][0], v1 = acc[ai][bj][m][1] * (1.0f / 32.0f) + bv[bj][1];
                    int w0 = __builtin_amdgcn_cvt_pk_fp8_f32(v0[0], v0[1], 0, false); w0 = __builtin_amdgcn_cvt_pk_fp8_f32(v0[2], v0[3], w0, true);
                    int w1 = __builtin_amdgcn_cvt_pk_fp8_f32(v1[0], v1[1], 0, false); w1 = __builtin_amdgcn_cvt_pk_fp8_f32(v1[2], v1[3], w1, true);
                    __builtin_amdgcn_raw_buffer_store_b64((u32x2){(unsigned)w0, (unsigned)w1}, rs_o, ro + (unsigned)(bj * HALF), 0, 0); } }
    }
};
struct EpiScaleBf16 {
    static constexpr bool PERM = true, AFTER_DRAIN = false;
    bf16_t* O; int ldc; float scale;
    __device__ __forceinline__ void operator()(const f32x4 (&acc)[2][2][4][2], const Unit& u, int wr, int wc, int fr, int fq) const {
        const int row0 = u.pm * BM + wr * 64 + fr, col0 = u.pn * BM + wc * 32 + 8 * fq;
#pragma unroll
        for (int ai = 0; ai < 2; ++ai)
#pragma unroll
            for (int m = 0; m < 4; ++m) { bf16_t* rowp = O + (size_t)(row0 + ai * HALF + m * 16) * ldc + col0;
#pragma unroll
                for (int bj = 0; bj < 2; ++bj) { const f32x4 v0 = acc[ai][bj][m][0] * scale, v1 = acc[ai][bj][m][1] * scale;
                    u32x4 w; w.x = cvt_pk_bf16(v0[0], v0[1]); w.y = cvt_pk_bf16(v0[2], v0[3]); w.z = cvt_pk_bf16(v1[0], v1[1]); w.w = cvt_pk_bf16(v1[2], v1[3]);
                    *(u32x4*)(rowp + bj * HALF) = w; } }
    }
};
struct EpiKV {
    static constexpr bool PERM = true, AFTER_DRAIN = false;
    unsigned char* KN; unsigned char* VT; int wv;
    __device__ __forceinline__ void operator()(const f32x4 (&acc)[2][2][4][2], const Unit& u, int, int, int, int) const {
        asm volatile("" ::: "memory");
        const int t_ = opaque_tid(wv), wid_ = t_ >> 6, wr = wid_ >> 2, wc = wid_ & 3, fr = t_ & 15, fq = (t_ & 63) >> 4;
        const unsigned lrow = (unsigned)(wr * 64 + fr); const int j0 = wc * 32 + 8 * fq;
        if (wc < 2) {
            const auto rs = __builtin_amdgcn_make_buffer_rsrc((void*)(KN + (size_t)u.pm * (BM * 1024) + 2 * u.pn * 64), 0, 0x7fffffff, 0x00020000);
#pragma unroll
            for (int ai = 0; ai < 2; ++ai)
#pragma unroll
                for (int m = 0; m < 4; ++m) { const unsigned ro = (lrow + (unsigned)(ai * HALF + m * 16)) * 1024u + (unsigned)j0;
#pragma unroll
                    for (int bj = 0; bj < 2; ++bj) { const f32x4 v0 = acc[ai][bj][m][0], v1 = acc[ai][bj][m][1];
                        int w0 = __builtin_amdgcn_cvt_pk_fp8_f32(v0[0], v0[1], 0, false); w0 = __builtin_amdgcn_cvt_pk_fp8_f32(v0[2], v0[3], w0, true);
                        int w1 = __builtin_amdgcn_cvt_pk_fp8_f32(v1[0], v1[1], 0, false); w1 = __builtin_amdgcn_cvt_pk_fp8_f32(v1[2], v1[3], w1, true);
                        __builtin_amdgcn_raw_buffer_store_b64((u32x2){(unsigned)w0, (unsigned)w1}, rs, ro + (unsigned)(bj * 64), 0, 0); } }
        } else {
            const int rb = u.pm * BM; const int bb = rb < 65536 ? (rb >> 13) : ((rb - 65536) >> 8), tile0 = rb < 65536 ? ((rb & 8191) >> 6) : 128;
            const auto rs = __builtin_amdgcn_make_buffer_rsrc((void*)(VT + ((size_t)((bb * 16 + 2 * u.pn) * 132 + tile0)) * 4096), 0, 0x7fffffff, 0x00020000);
            const unsigned d0 = (unsigned)(j0 - 64);
#pragma unroll
            for (int ai = 0; ai < 2; ++ai)
#pragma unroll
                for (int m = 0; m < 4; ++m) { const unsigned lr = lrow + (unsigned)(ai * HALF + m * 16), key = lr & 63u;
                    const unsigned ro = (lr >> 6) * 4096u + d0 * 64u + 32u * ((key >> 2) & 1u) + 16u * (key >> 5) + 4u * ((key >> 3) & 3u) + (key & 3u);
#pragma unroll
                    for (int bj = 0; bj < 2; ++bj) { const f32x4 v0 = acc[ai][bj][m][0], v1 = acc[ai][bj][m][1]; const unsigned bo = ro + (unsigned)(bj * 132 * 4096);
                        const int w0 = __builtin_amdgcn_cvt_pk_fp8_f32(v0[0], v0[1], 0, false), w1 = __builtin_amdgcn_cvt_pk_fp8_f32(v0[2], v0[3], 0, false);
                        const int w2 = __builtin_amdgcn_cvt_pk_fp8_f32(v1[0], v1[1], 0, false), w3 = __builtin_amdgcn_cvt_pk_fp8_f32(v1[2], v1[3], 0, false);
                        __builtin_amdgcn_raw_buffer_store_b8((unsigned char)w0, rs, bo, 0, 0); __builtin_amdgcn_raw_buffer_store_b8((unsigned char)(w0 >> 8), rs, bo + 64u, 0, 0);
                        __builtin_amdgcn_raw_buffer_store_b8((unsigned char)w1, rs, bo + 128u, 0, 0); __builtin_amdgcn_raw_buffer_store_b8((unsigned char)(w1 >> 8), rs, bo + 192u, 0, 0);
                        __builtin_amdgcn_raw_buffer_store_b8((unsigned char)w2, rs, bo + 256u, 0, 0); __builtin_amdgcn_raw_buffer_store_b8((unsigned char)(w2 >> 8), rs, bo + 320u, 0, 0);
                        __builtin_amdgcn_raw_buffer_store_b8((unsigned char)w3, rs, bo + 384u, 0, 0); __builtin_amdgcn_raw_buffer_store_b8((unsigned char)(w3 >> 8), rs, bo + 448u, 0, 0); } }
        }
    }
};
}
namespace att {
using bf16 = __hip_bfloat16;
using bf16x8 = __attribute__((ext_vector_type(8))) short;
using s16x4  = __attribute__((ext_vector_type(4))) short;
using f32x16 = __attribute__((ext_vector_type(16))) float;
using u32x4  = __attribute__((ext_vector_type(4))) unsigned;
using u32x2  = __attribute__((ext_vector_type(2))) unsigned;
using f32x4  = __attribute__((ext_vector_type(4))) float;
#define ATT_SBAR() __builtin_amdgcn_sched_barrier(0)
constexpr float THR = 8.f;
__device__ __forceinline__ int crow(int r, int hi) { return (r & 3) + 8 * (r >> 2) + 4 * hi; }
__device__ __forceinline__ unsigned cvtpk(float lo, float hi) { unsigned r; asm volatile("v_cvt_pk_bf16_f32 %0, %1, %2" : "=v"(r) : "v"(lo), "v"(hi)); return r; }
__device__ __forceinline__ void partialSM(f32x16& p0, f32x16& p1, float& m_reg, float& alpha) {
  float pmax = p0[0];
#pragma unroll
  for (int r = 1; r < 16; ++r) pmax = fmaxf(pmax, p0[r]);
#pragma unroll
  for (int r = 0; r < 16; ++r) pmax = fmaxf(pmax, p1[r]);
  { auto rr = __builtin_amdgcn_permlane32_swap(__float_as_uint(pmax), __float_as_uint(pmax), false, false); pmax = fmaxf(__uint_as_float(rr[0]), __uint_as_float(rr[1])); }
  if (__builtin_expect(__all(pmax - m_reg <= THR), 1)) { alpha = 1.f; }
  else { const float mn = fmaxf(m_reg, pmax); alpha = __builtin_amdgcn_exp2f(m_reg - mn); m_reg = mn; }
  const float mneg = -m_reg;
#pragma unroll
  for (int r = 0; r < 16; ++r) p0[r] += mneg;
#pragma unroll
  for (int r = 0; r < 16; ++r) p1[r] += mneg;
#pragma unroll
  for (int r = 0; r < 16; ++r) p0[r] = __builtin_amdgcn_exp2f(p0[r]);
}
__device__ __forceinline__ void finishSM(f32x16& p0, f32x16& p1, float alpha, float& l_reg, bf16x8& pa0, bf16x8& pa1, bf16x8& pa2, bf16x8& pa3) {
#pragma unroll
  for (int r = 0; r < 16; ++r) p1[r] = __builtin_amdgcn_exp2f(p1[r]);
  float ps = 0;
#pragma unroll
  for (int r = 0; r < 16; ++r) ps += p0[r];
#pragma unroll
  for (int r = 0; r < 16; ++r) ps += p1[r];
  { auto rr = __builtin_amdgcn_permlane32_swap(__float_as_uint(ps), __float_as_uint(ps), false, false); ps = __uint_as_float(rr[0]) + __uint_as_float(rr[1]); }
  l_reg = l_reg * alpha + ps;
#define ATT_PK4(P, BASE, OUT) do { unsigned a0 = cvtpk(P[BASE + 0], P[BASE + 1]), a1 = cvtpk(P[BASE + 2], P[BASE + 3]);   \
    unsigned b0 = cvtpk(P[BASE + 4], P[BASE + 5]), b1 = cvtpk(P[BASE + 6], P[BASE + 7]);                              \
    auto r0 = __builtin_amdgcn_permlane32_swap(a0, b0, false, false); auto r1 = __builtin_amdgcn_permlane32_swap(a1, b1, false, false); \
    u32x4 w = {r0[0], r1[0], r0[1], r1[1]}; OUT = *reinterpret_cast<bf16x8*>(&w); } while (0)
  ATT_PK4(p0, 0, pa0); ATT_PK4(p0, 8, pa1); ATT_PK4(p1, 0, pa2); ATT_PK4(p1, 8, pa3);
#undef ATT_PK4
}
__device__ __forceinline__ int v_st(int k, int c) { const int kk = (k & ~0xC) | ((k & 4) << 1) | ((k & 8) >> 1); return ((kk >> 3) * 2 + (c >> 5)) * 512 + ((kk & 7) * 32 + (c & 31)) * 2; }
__device__ __forceinline__ int v_rd_base(int lane) { return ((lane & 3) << 3) | (((lane >> 2) & 3) << 6) | (((lane >> 4) & 1) << 5) | (((lane >> 5) & 1) << 8); }
constexpr int v_rd_off(int d0, int ks, int half) { return d0 * 512 + ks * 2048 + half * 1024; }
template <int OFF> __device__ __forceinline__ s16x4 tr_read(int vb) { s16x4 r; asm volatile("ds_read_b64_tr_b16 %0, %1 offset:%2" : "=&v"(r) : "v"(vb), "i"(OFF) : "memory"); return r; }
template <int D0> __device__ __forceinline__ void pv_one(f32x16& od, int vb, bf16x8 pa0, bf16x8 pa1, bf16x8 pa2, bf16x8 pa3) {
  const s16x4 l0 = tr_read<v_rd_off(D0, 0, 0)>(vb), h0 = tr_read<v_rd_off(D0, 0, 1)>(vb), l1 = tr_read<v_rd_off(D0, 1, 0)>(vb), h1 = tr_read<v_rd_off(D0, 1, 1)>(vb);
  const s16x4 l2 = tr_read<v_rd_off(D0, 2, 0)>(vb), h2 = tr_read<v_rd_off(D0, 2, 1)>(vb), l3 = tr_read<v_rd_off(D0, 3, 0)>(vb), h3 = tr_read<v_rd_off(D0, 3, 1)>(vb);
  asm volatile("s_waitcnt lgkmcnt(0)" ::: "memory"); ATT_SBAR();
#define ATT_PKV(L, H) (bf16x8){L[0], L[1], L[2], L[3], H[0], H[1], H[2], H[3]}
  od = __builtin_amdgcn_mfma_f32_32x32x16_bf16(pa0, ATT_PKV(l0, h0), od, 0, 0, 0);
  od = __builtin_amdgcn_mfma_f32_32x32x16_bf16(pa1, ATT_PKV(l1, h1), od, 0, 0, 0);
  od = __builtin_amdgcn_mfma_f32_32x32x16_bf16(pa2, ATT_PKV(l2, h2), od, 0, 0, 0);
  od = __builtin_amdgcn_mfma_f32_32x32x16_bf16(pa3, ATT_PKV(l3, h3), od, 0, 0, 0);
#undef ATT_PKV
}
__device__ __forceinline__ void pv2(f32x16* o, int vb, bf16x8 pa0, bf16x8 pa1, bf16x8 pa2, bf16x8 pa3) { pv_one<0>(o[0], vb, pa0, pa1, pa2, pa3); pv_one<1>(o[1], vb, pa0, pa1, pa2, pa3); }

#define MLA_KSWZ(row, colB) ((row) * 256 + ((colB) ^ (((row) & 15) << 4)))
constexpr int MLA_NS = 5, MLA_SHM_V = 8192, MLA_SHM_K = 16384, MLA_V_OFF = 0, MLA_K_OFF = MLA_NS * MLA_SHM_V, MLA_WS_OFF = MLA_K_OFF + MLA_NS * MLA_SHM_K, MLA_LDS = MLA_WS_OFF + 8 * 64 * 4;
__device__ __forceinline__ void mla_qkt(f32x16& p0, f32x16& p1, const char* Ks, const bf16x8* qr, const f32x16& negm, int r32, int hi) {
#pragma unroll
  for (int d0 = 0; d0 < 6; ++d0) { const int cb = (d0 * 16 + hi * 8) * 2;
    const bf16x8 b0 = *reinterpret_cast<const bf16x8*>(Ks + MLA_KSWZ(r32, cb));
    const bf16x8 b1 = *reinterpret_cast<const bf16x8*>(Ks + MLA_KSWZ(32 + r32, cb));
    if (d0 == 0) { p0 = __builtin_amdgcn_mfma_f32_32x32x16_bf16(b0, qr[0], negm, 0, 0, 0); p1 = __builtin_amdgcn_mfma_f32_32x32x16_bf16(b1, qr[0], negm, 0, 0, 0); }
    else { p0 = __builtin_amdgcn_mfma_f32_32x32x16_bf16(b0, qr[d0], p0, 0, 0, 0); p1 = __builtin_amdgcn_mfma_f32_32x32x16_bf16(b1, qr[d0], p1, 0, 0, 0); } }
}
__device__ __forceinline__ void mla_partialSM(f32x16& p0, f32x16& p1, float& m_reg, f32x16& negm, float& alpha) {
  float pmax = p0[0];
#pragma unroll
  for (int r = 1; r < 16; ++r) pmax = fmaxf(pmax, p0[r]);
#pragma unroll
  for (int r = 0; r < 16; ++r) pmax = fmaxf(pmax, p1[r]);
  { auto rr = __builtin_amdgcn_permlane32_swap(__float_as_uint(pmax), __float_as_uint(pmax), false, false); pmax = fmaxf(__uint_as_float(rr[0]), __uint_as_float(rr[1])); }
  alpha = 1.f;
  if (__builtin_expect(!__all(pmax <= THR), 0)) { const float dl = fmaxf(pmax, 0.f); m_reg += dl; alpha = __builtin_amdgcn_exp2f(-dl);
#pragma unroll
    for (int r = 0; r < 16; ++r) { p0[r] -= dl; p1[r] -= dl; }
#pragma unroll
    for (int r = 0; r < 16; ++r) negm[r] = -m_reg; }
#pragma unroll
  for (int r = 0; r < 16; ++r) p0[r] = __builtin_amdgcn_exp2f(p0[r]);
}
__device__ __forceinline__ void mla_unit(const bf16* __restrict__ Q, const bf16* __restrict__ KN, const bf16* __restrict__ KR, const bf16* __restrict__ V, unsigned char* __restrict__ O, const float* __restrict__ rope, int b, int h, int qrow0, char* lds, const int wv) {
  const int tid = opaque_tid(wv), wid = tid >> 6, lane = tid & 63, r32 = lane & 31, hi = lane >> 5;
  char* V_lds = lds + MLA_V_OFF; char* K_lds = lds + MLA_K_OFF;
  float* ws = (float*)(lds + MLA_WS_OFF) + wid * 64; float* li_l = ws; float* al_l = ws + 32;
  float m_reg = 0.f, l_reg = 0; f32x16 o[2] = {}; bf16x8 qr[6]; f32x16 negm = {};
  const bf16* Qw = Q + (size_t)(qrow0 + wid * 32 + r32) * 1536 + h * 96 + hi * 8;
#pragma unroll
  for (int d0 = 0; d0 < 6; ++d0) qr[d0] = *reinterpret_cast<const bf16x8*>(Qw + d0 * 16);
  { const unsigned s = (unsigned)(qrow0 + wid * 32 + r32) & 8191u;
#pragma unroll
    for (int d0 = 4; d0 < 6; ++d0) { const float* tp = rope + (s * 16u + (unsigned)(8 * (d0 - 4) + 4 * hi)) * 2u; const f32x4 t0 = *reinterpret_cast<const f32x4*>(tp), t1 = *reinterpret_cast<const f32x4*>(tp + 4);
      float e[8];
#pragma unroll
      for (int j = 0; j < 8; ++j) e[j] = __uint_as_float(((unsigned)(unsigned short)qr[d0][j]) << 16);
      u32x4 w; w.x = cvtpk(e[0] * t0[0] - e[1] * t0[1], e[0] * t0[1] + e[1] * t0[0]); w.y = cvtpk(e[2] * t0[2] - e[3] * t0[3], e[2] * t0[3] + e[3] * t0[2]);
      w.z = cvtpk(e[4] * t1[0] - e[5] * t1[1], e[4] * t1[1] + e[5] * t1[0]); w.w = cvtpk(e[6] * t1[2] - e[7] * t1[3], e[6] * t1[3] + e[7] * t1[2]);
      qr[d0] = *reinterpret_cast<bf16x8*>(&w); } }
  const int sr = tid >> 3, c8 = tid & 7;
  const int vst = v_st(sr, c8 * 8), kst = MLA_KSWZ(sr, c8 * 16), krst = MLA_KSWZ(sr, 128 + (c8 >> 1) * 16) + (c8 & 1) * 8;
  const int vb0 = (int)(uintptr_t)V_lds + v_rd_base(lane);
  struct { bf16x8 v, kn; u32x2 kr; } st_[1];
  const size_t lat0 = (size_t)b * 8192, ctx0 = (size_t)65536 + (size_t)b * 256;
#define MLA_TOK(t) ((t) < 128 ? lat0 + (size_t)(t) * 64 : ctx0 + (size_t)((t) - 128) * 64)
#define MLA_SLOAD(i, t) do { const size_t tk = MLA_TOK(t) + sr; st_[i].v = *reinterpret_cast<const bf16x8*>(V + tk * 1024 + h * 64 + c8 * 8); \
    st_[i].kn = *reinterpret_cast<const bf16x8*>(KN + tk * 1024 + h * 64 + c8 * 8); st_[i].kr = *reinterpret_cast<const u32x2*>(KR + tk * 32 + c8 * 4); } while (0)
#define MLA_SWRITE(slot, i) do { *(bf16x8*)(V_lds + (slot) * MLA_SHM_V + vst) = st_[i].v; *(bf16x8*)(K_lds + (slot) * MLA_SHM_K + kst) = st_[i].kn; *(u32x2*)(K_lds + (slot) * MLA_SHM_K + krst) = st_[i].kr; } while (0)
#define MLA_RESC(a) do { if (__any((a) < 1.f)) { if (hi == 0) al_l[r32] = (a); asm volatile("s_waitcnt lgkmcnt(0)" ::: "memory"); \
    _Pragma("unroll") for (int d = 0; d < 2; ++d) _Pragma("unroll") for (int r = 0; r < 16; ++r) o[d][r] *= al_l[crow(r, hi)]; } } while (0)
  f32x16 pA0, pA1, pB0, pB1; float alA, alB; bf16x8 pa0, pa1, pa2, pa3; constexpr int NT = 132;
#define MLA_INC(x) ((x) == MLA_NS - 1 ? 0 : (x) + 1)
  MLA_SLOAD(0, 0); MLA_SWRITE(0, 0); MLA_SLOAD(0, 1); MLA_SWRITE(1, 0); MLA_SLOAD(0, 2); MLA_SWRITE(2, 0); MLA_SLOAD(0, 3);
  __syncthreads();
  mla_qkt(pA0, pA1, K_lds, qr, negm, r32, hi); mla_partialSM(pA0, pA1, m_reg, negm, alA);
  int s0 = 0;
  for (int t = 1; t + 1 < NT; t += 2) {
    const int s1 = MLA_INC(s0), s2 = MLA_INC(s1), s3 = MLA_INC(s2), s4 = MLA_INC(s3);
    __syncthreads();
    MLA_SWRITE(s3, 0); if (t + 3 < NT) MLA_SLOAD(0, t + 3);
    ATT_SBAR(); mla_qkt(pB0, pB1, K_lds + s1 * MLA_SHM_K, qr, negm, r32, hi);
    finishSM(pA0, pA1, alA, l_reg, pa0, pa1, pa2, pa3); ATT_SBAR();
    pv2(o, vb0 + s0 * MLA_SHM_V, pa0, pa1, pa2, pa3); mla_partialSM(pB0, pB1, m_reg, negm, alB);
    MLA_RESC(alB);
    if (t + 3 < NT) { MLA_SWRITE(s4, 0); if (t + 4 < NT) MLA_SLOAD(0, t + 4); }
    ATT_SBAR(); mla_qkt(pA0, pA1, K_lds + s2 * MLA_SHM_K, qr, negm, r32, hi);
    finishSM(pB0, pB1, alB, l_reg, pa0, pa1, pa2, pa3); ATT_SBAR();
    pv2(o, vb0 + s1 * MLA_SHM_V, pa0, pa1, pa2, pa3); mla_partialSM(pA0, pA1, m_reg, negm, alA);
    MLA_RESC(alA);
    s0 = s2;
  }
  { const int s1 = MLA_INC(s0);
    __syncthreads();
    ATT_SBAR(); mla_qkt(pB0, pB1, K_lds + s1 * MLA_SHM_K, qr, negm, r32, hi);
    finishSM(pA0, pA1, alA, l_reg, pa0, pa1, pa2, pa3); ATT_SBAR();
    pv2(o, vb0 + s0 * MLA_SHM_V, pa0, pa1, pa2, pa3); mla_partialSM(pB0, pB1, m_reg, negm, alB);
    MLA_RESC(alB);
    finishSM(pB0, pB1, alB, l_reg, pa0, pa1, pa2, pa3); ATT_SBAR();
    pv2(o, vb0 + s1 * MLA_SHM_V, pa0, pa1, pa2, pa3); }
#undef MLA_INC
  if (hi == 0) li_l[r32] = l_reg; asm volatile("s_waitcnt lgkmcnt(0)" ::: "memory");
  float rli[16];
#pragma unroll
  for (int r = 0; r < 16; ++r) rli[r] = __builtin_amdgcn_rcpf(li_l[crow(r, hi)]);
  unsigned char* Ow = O + (size_t)(qrow0 + wid * 32) * 1024 + h * 64;
#pragma unroll
  for (int r = 0; r < 16; ++r) { const int orow = crow(r, hi);
#pragma unroll
    for (int d0 = 0; d0 < 2; ++d0) Ow[(size_t)orow * 1024 + d0 * 32 + r32] = (unsigned char)__builtin_amdgcn_cvt_pk_fp8_f32(o[d0][r] * rli[r], 0.f, 0, false); }
  __syncthreads();
#undef MLA_TOK
#undef MLA_SLOAD
#undef MLA_SWRITE
#undef MLA_RESC
}

typedef int v8i __attribute__((ext_vector_type(8)));
typedef int v4i __attribute__((ext_vector_type(4)));
constexpr int M8_NS = 5, M8_KP = 144, M8_K_BYTES = 64 * M8_KP, M8_VP = 80, M8_V_BYTES = 64 * M8_VP, M8_V_OFF = 0, M8_K_OFF = M8_NS * M8_V_BYTES, M8_WS_OFF = M8_K_OFF + M8_NS * M8_K_BYTES, M8_LDS = M8_WS_OFF + 8 * 64 * 4;
#define M8_CAT(x, y) __builtin_shufflevector(x, y, 0, 1, 2, 3, 4, 5, 6, 7)
#define M8_MFMA(a, b, c) __builtin_amdgcn_mfma_scale_f32_32x32x64_f8f6f4(a, b, c, 0, 0, 0, 0x7f7f7f7f, 0, 0x7f7f7f7f)
__device__ __forceinline__ unsigned pk8(float a, float b, float c, float d) { int w = __builtin_amdgcn_cvt_pk_fp8_f32(a, b, 0, false); w = __builtin_amdgcn_cvt_pk_fp8_f32(c, d, w, true); return (unsigned)w; }
__device__ __forceinline__ void mla8_qkt(f32x16& p0, f32x16& p1, const char* Ks, const v8i& qa, const v8i& qb, const f32x16& negm, int r32, int hi) {
  const char* k0 = Ks + r32 * M8_KP + 32 * hi; const char* k1 = k0 + 32 * M8_KP;
  const v8i a0 = M8_CAT(*reinterpret_cast<const v4i*>(k0), *reinterpret_cast<const v4i*>(k0 + 16)), a1 = M8_CAT(*reinterpret_cast<const v4i*>(k1), *reinterpret_cast<const v4i*>(k1 + 16));
  const v8i b0 = M8_CAT(*reinterpret_cast<const v4i*>(k0 + 64), *reinterpret_cast<const v4i*>(k0 + 80)), b1 = M8_CAT(*reinterpret_cast<const v4i*>(k1 + 64), *reinterpret_cast<const v4i*>(k1 + 80));
  p0 = M8_MFMA(a0, qa, negm); p1 = M8_MFMA(a1, qa, negm);
  p0 = M8_MFMA(b0, qb, p0);   p1 = M8_MFMA(b1, qb, p1);
}
__device__ __forceinline__ void mla8_finishSM(f32x16& p0, f32x16& p1, v8i& pa) {
#pragma unroll
  for (int r = 0; r < 16; ++r) p1[r] = __builtin_amdgcn_exp2f(p1[r]);
#pragma unroll
  for (int i = 0; i < 4; ++i) { pa[i] = (int)pk8(p0[4 * i], p0[4 * i + 1], p0[4 * i + 2], p0[4 * i + 3]); pa[4 + i] = (int)pk8(p1[4 * i], p1[4 * i + 1], p1[4 * i + 2], p1[4 * i + 3]); }
}
__device__ __forceinline__ void mla8_pv(f32x16* o, const char* Vs, const v8i& pa, int r32, int hi) {
  const char* v0 = Vs + r32 * M8_VP + 32 * hi; const char* v1 = v0 + 32 * M8_VP;
  const v8i f0 = M8_CAT(*reinterpret_cast<const v4i*>(v0), *reinterpret_cast<const v4i*>(v0 + 16)), f1 = M8_CAT(*reinterpret_cast<const v4i*>(v1), *reinterpret_cast<const v4i*>(v1 + 16));
  o[0] = M8_MFMA(pa, f0, o[0]); o[1] = M8_MFMA(pa, f1, o[1]);
  const v8i ones = {0x38383838, 0x38383838, 0x38383838, 0x38383838, 0x38383838, 0x38383838, 0x38383838, 0x38383838};
  o[2] = M8_MFMA(pa, ones, o[2]);
}
__device__ __forceinline__ void mla8_zero_pad(char* lds, const int wv) {
  const int tid = opaque_tid(wv); char* K_lds = lds + M8_K_OFF;
  for (int i = tid; i < M8_NS * 64 * 2; i += 512) { const int slot = i >> 7, row = (i >> 1) & 63, q = i & 1; *reinterpret_cast<v4i*>(K_lds + slot * M8_K_BYTES + row * M8_KP + 96 + 16 * q) = (v4i){0, 0, 0, 0}; }
  __syncthreads();
}
__device__ __forceinline__ unsigned pk8n(float a, float b, float c, float d) { int w = __builtin_amdgcn_cvt_pk_fp8_f32(a, b, __float_as_int(a), false); w = __builtin_amdgcn_cvt_pk_fp8_f32(c, d, w, true); return (unsigned)w; }
__device__ __forceinline__ float max3f(float a, float b, float c) { float d; asm volatile("v_max3_f32 %0, %1, %2, %3" : "=v"(d) : "v"(a), "v"(b), "v"(c)); return d; }
__device__ __forceinline__ float max16(float s, const f32x16& p) {
#pragma unroll
  for (int r = 0; r < 16; r += 2) s = max3f(s, p[r], p[r + 1]);
  return s;
}
__device__ __forceinline__ void mla8_unit(const bf16* __restrict__ Q, const unsigned char* __restrict__ K8, const unsigned char* __restrict__ KR8, const unsigned char* __restrict__ V8, unsigned char* __restrict__ O,
                                          const float* __restrict__ rope, int b, int h, int qrow0, char* lds, const int wv) {
  const int tid = opaque_tid(wv), wid = tid >> 6, lane = tid & 63, r32 = lane & 31, hi = lane >> 5;
  char* V_lds = lds + M8_V_OFF; char* K_lds = lds + M8_K_OFF;
  float* ws = (float*)(lds + M8_WS_OFF) + wid * 64; float* al_l = ws + 32;
  f32x16 o[3] = {}; f32x16 negm = {};
  v8i qa, qb;
  { const bf16* Qw = Q + (size_t)(qrow0 + wid * 32 + r32) * 1536 + h * 96;
    float e[32];
#pragma unroll
    for (int c = 0; c < 4; ++c) { const bf16x8 v = *reinterpret_cast<const bf16x8*>(Qw + 32 * hi + 8 * c);
#pragma unroll
      for (int j = 0; j < 8; ++j) e[8 * c + j] = __uint_as_float(((unsigned)(unsigned short)v[j]) << 16); }
#pragma unroll
    for (int i = 0; i < 8; ++i) qa[i] = (int)pk8(e[4 * i], e[4 * i + 1], e[4 * i + 2], e[4 * i + 3]);
#pragma unroll
    for (int c = 0; c < 4; ++c) { const bf16x8 v = *reinterpret_cast<const bf16x8*>(Qw + 64 + 8 * c);
#pragma unroll
      for (int j = 0; j < 8; ++j) e[8 * c + j] = __uint_as_float(((unsigned)(unsigned short)v[j]) << 16); }
    const float* tp = rope + (size_t)((unsigned)(qrow0 + wid * 32 + r32) & 8191u) * 32;
#pragma unroll
    for (int c = 0; c < 8; ++c) { const f32x4 t = *reinterpret_cast<const f32x4*>(tp + 4 * c);
      const float x0 = e[4 * c], x1 = e[4 * c + 1], x2 = e[4 * c + 2], x3 = e[4 * c + 3];
      e[4 * c] = x0 * t[0] - x1 * t[1]; e[4 * c + 1] = x0 * t[1] + x1 * t[0]; e[4 * c + 2] = x2 * t[2] - x3 * t[3]; e[4 * c + 3] = x2 * t[3] + x3 * t[2]; }
#pragma unroll
    for (int i = 0; i < 8; ++i) qb[i] = hi ? 0 : (int)pk8(e[4 * i], e[4 * i + 1], e[4 * i + 2], e[4 * i + 3]); }
  const int wsc = __builtin_amdgcn_readfirstlane(wid); const bool knope = wsc < 4; const bool kdo = wsc < 6;
  const int kkey = knope ? (tid >> 2) : ((tid - 256) >> 1), kch = knope ? (tid & 3) : 4 + (tid & 1);
  const int kst = kkey * M8_KP + kch * 16;
  const unsigned char* kbase = knope ? K8 + h * 64 : KR8; const unsigned kstride = knope ? 1024u : 32u; const unsigned kvoff = knope ? (unsigned)(kkey * 1024 + kch * 16) : (unsigned)(kkey * 32 + (kch - 4) * 16);
  const bool vdo = wsc < 4; const int vd = (tid >> 2) & 63, vc = tid & 3;
  const int vst = vd * M8_VP + 16 * vc; const unsigned vvoff = (unsigned)(vd * 64 + 16 * vc);
  v4i skv = {0, 0, 0, 0}, svv = {0, 0, 0, 0}, skw = {0, 0, 0, 0}, svw = {0, 0, 0, 0};
  const unsigned char* vblk0 = V8 + (size_t)((b * 16 + h) * 132) * 4096;
  const unsigned lat0 = (unsigned)b * 8192u, ctx0 = 65536u + (unsigned)b * 256u;
#define M8_TOK(t) ((t) < 128 ? lat0 + (unsigned)(t) * 64u : ctx0 + (unsigned)((t) - 128) * 64u)
#define M8_SLOADX(t, KV, VV) do { const unsigned tk0 = M8_TOK(t); if (kdo) KV = *reinterpret_cast<const v4i*>(kbase + (size_t)tk0 * kstride + kvoff); \
    if (vdo) VV = *reinterpret_cast<const v4i*>(vblk0 + (size_t)(t) * 4096 + vvoff); } while (0)
#define M8_SWRITEX(slot, KV, VV) do { if (kdo) *reinterpret_cast<v4i*>(K_lds + (slot) * M8_K_BYTES + kst) = KV; if (vdo) *reinterpret_cast<v4i*>(V_lds + (slot) * M8_V_BYTES + vst) = VV; } while (0)
#define M8_SLOAD(t) M8_SLOADX(t, skv, svv)
#define M8_SWRITE(slot) M8_SWRITEX(slot, skv, svv)
#define M8_RESC(a) do { if (__any((a) < 1.f)) { if (hi == 0) al_l[r32] = (a); asm volatile("s_waitcnt lgkmcnt(0)" ::: "memory"); \
    _Pragma("unroll") for (int r = 0; r < 16; ++r) { const float f_ = al_l[crow(r, hi)]; o[0][r] *= f_; o[1][r] *= f_; o[2][r] *= f_; } } } while (0)
#define M8_INC(x) ((x) == M8_NS - 1 ? 0 : (x) + 1)
  f32x16 pX0, pA1, pB1; constexpr int NT = 132;
  v8i ka, kb, kc, kd, f0, f1;
  v8i ones8 = {0x38383838, 0x38383838, 0x38383838, 0x38383838, 0x38383838, 0x38383838, 0x38383838, 0x38383838}; asm volatile("" : "+v"(ones8));
#define M8_SB() __builtin_amdgcn_sched_barrier(0)
#define M8_PIN(x) asm volatile("" : "+v"(x))
#define M8_LDK(s) do { const char* k0_ = K_lds + (s) * M8_K_BYTES + r32 * M8_KP + 32 * hi; const char* k1_ = k0_ + 32 * M8_KP; \
    ka = M8_CAT(*reinterpret_cast<const v4i*>(k0_), *reinterpret_cast<const v4i*>(k0_ + 16)); kc = M8_CAT(*reinterpret_cast<const v4i*>(k1_), *reinterpret_cast<const v4i*>(k1_ + 16)); \
    kb = M8_CAT(*reinterpret_cast<const v4i*>(k0_ + 64), *reinterpret_cast<const v4i*>(k0_ + 80)); kd = M8_CAT(*reinterpret_cast<const v4i*>(k1_ + 64), *reinterpret_cast<const v4i*>(k1_ + 80)); } while (0)
#define M8_LDV(s) do { const char* v0_ = V_lds + (s) * M8_V_BYTES + r32 * M8_VP + 32 * hi; const char* v1_ = v0_ + 32 * M8_VP; \
    f0 = M8_CAT(*reinterpret_cast<const v4i*>(v0_), *reinterpret_cast<const v4i*>(v0_ + 16)); f1 = M8_CAT(*reinterpret_cast<const v4i*>(v1_), *reinterpret_cast<const v4i*>(v1_ + 16)); } while (0)
#define M8_EX(P, I) P[I] = __builtin_amdgcn_exp2f(P[I])
#define M8_PK(P, I, W) W = (int)pk8n(P[I], P[I + 1], P[I + 2], P[I + 3])
#define M8_E4(P, I, W) do { M8_EX(P, I); M8_EX(P, I + 1); M8_EX(P, I + 2); M8_EX(P, I + 3); M8_PK(P, I, W); } while (0)
#define M8_PIN2(a_, b_) asm volatile("" : "+v"(a_), "+v"(b_))
#define M8_PIN4(a_, b_, c_, d_) asm volatile("" : "+v"(a_), "+v"(b_), "+v"(c_), "+v"(d_))
#define M8_PIN6(a_, b_, c_, d_, e_, f_) asm volatile("" : "+v"(a_), "+v"(b_), "+v"(c_), "+v"(d_), "+v"(e_), "+v"(f_))
#define M8_TAIL(C0, C1, PN, MX) do { \
    if (__builtin_expect(!__all((MX) <= THR), 0)) { const float dl_ = fmaxf((MX), 0.f); const float al_ = __builtin_amdgcn_exp2f(-dl_); \
      _Pragma("unroll") for (int r_ = 0; r_ < 16; ++r_) { C0[r_] -= dl_; C1[r_] -= dl_; negm[r_] -= dl_; } \
      if (hi == 0) al_l[r32] = al_; asm volatile("s_waitcnt lgkmcnt(0)" ::: "memory"); \
      _Pragma("unroll") for (int r_ = 0; r_ < 16; ++r_) { const float f_ = al_l[crow(r_, hi)]; o[0][r_] *= f_; o[1][r_] *= f_; o[2][r_] *= f_; } } \
    _Pragma("unroll") for (int r_ = 0; r_ < 16; ++r_) M8_EX(C0, r_); \
    M8_PK(C0, 0, PN[0]); M8_PK(C0, 4, PN[1]); M8_PK(C0, 8, PN[2]); M8_PK(C0, 12, PN[3]); } while (0)
#define M8_MX8(P, I) max3f(max3f(max3f(P[I], P[I + 1], P[I + 2]), P[I + 3], P[I + 4]), max3f(P[I + 5], P[I + 6], P[I + 7]), P[I + 5])
#define M8_MXFIN(MX) do { auto rr_ = __builtin_amdgcn_permlane32_swap(__float_as_uint(MX), __float_as_uint(MX), false, false); MX = max3f(__uint_as_float(rr_[0]), __uint_as_float(rr_[1]), __uint_as_float(rr_[1])); } while (0)
#define M8_HALF(C0, C1, PC, PN, PRV1, VS, NEXTK) do { float mxa_, mxb_; \
    M8_PIN(PRV1); M8_LDV(VS); M8_SB(); \
    C0 = M8_MFMA(ka, qa, negm); M8_SB(); M8_EX(PRV1, 0); M8_EX(PRV1, 1); M8_EX(PRV1, 2); M8_EX(PRV1, 3); M8_EX(PRV1, 4); M8_EX(PRV1, 5); M8_PIN6(PRV1[0], PRV1[1], PRV1[2], PRV1[3], PRV1[4], PRV1[5]); M8_SB(); \
    C1 = M8_MFMA(kc, qa, negm); M8_SB(); M8_EX(PRV1, 6); M8_EX(PRV1, 7); M8_EX(PRV1, 8); M8_EX(PRV1, 9); M8_EX(PRV1, 10); M8_EX(PRV1, 11); M8_PK(PRV1, 0, PC[4]); M8_PIN6(PRV1[6], PRV1[7], PRV1[8], PRV1[9], PRV1[10], PRV1[11]); M8_PIN(PC[4]); M8_SB(); \
    C0 = M8_MFMA(kb, qb, C0);   M8_SB(); M8_EX(PRV1, 12); M8_EX(PRV1, 13); M8_EX(PRV1, 14); M8_EX(PRV1, 15); M8_PK(PRV1, 4, PC[5]); M8_PK(PRV1, 8, PC[6]); M8_PIN4(PRV1[12], PRV1[13], PRV1[14], PRV1[15]); M8_PIN2(PC[5], PC[6]); M8_SB(); \
    C1 = M8_MFMA(kd, qb, C1);   M8_SB(); M8_PK(PRV1, 12, PC[7]); M8_PIN(PC[7]); M8_SB(); \
    o[0] = M8_MFMA(PC, f0, o[0]);    M8_SB(); mxa_ = M8_MX8(C0, 0); mxb_ = M8_MX8(C0, 8); M8_SB(); \
    o[1] = M8_MFMA(PC, f1, o[1]);    M8_SB(); mxa_ = max3f(mxa_, M8_MX8(C1, 0), mxb_); mxb_ = M8_MX8(C1, 8); M8_SB(); \
    o[2] = M8_MFMA(PC, ones8, o[2]); M8_SB(); \
    NEXTK; mxa_ = max3f(mxa_, mxb_, mxb_); M8_MXFIN(mxa_); M8_SB(); \
    M8_TAIL(C0, C1, PN, mxa_); } while (0)
  v8i paA, paB;
  M8_SLOAD(0); M8_SWRITE(0); M8_SLOAD(1); M8_SWRITE(1); M8_SLOAD(2); M8_SWRITE(2); M8_SLOAD(3); M8_SLOADX(4, skw, svw);
  __syncthreads();
  { M8_LDK(0); pX0 = M8_MFMA(ka, qa, negm); pA1 = M8_MFMA(kc, qa, negm); pX0 = M8_MFMA(kb, qb, pX0); pA1 = M8_MFMA(kd, qb, pA1);
    asm volatile("s_nop 15\n\ts_nop 15\n\ts_nop 15\n\ts_nop 15\n\ts_nop 15" ::: "memory");
    float mx_ = max16(max16(pX0[0], pX0), pA1); M8_MXFIN(mx_);
    M8_LDK(1);
    M8_TAIL(pX0, pA1, paA, mx_); }
  int s0 = 0;
#pragma unroll 1
  for (int t = 1; t + 1 < NT; t += 2) {
    const int s1 = M8_INC(s0), s2 = M8_INC(s1), s3 = M8_INC(s2), s4 = M8_INC(s3);
    M8_SWRITE(s3); if (t + 4 < NT) M8_SLOAD(t + 4);
    M8_HALF(pX0, pB1, paA, paB, pA1, s0, M8_LDK(s2));
    if (t + 3 < NT) { M8_SWRITEX(s4, skw, svw); if (t + 5 < NT) M8_SLOADX(t + 5, skw, svw); }
    M8_HALF(pX0, pA1, paB, paA, pB1, s1, (void)0);
    __syncthreads(); M8_LDK(s3);
    s0 = s2;
  }
  { const int s1 = M8_INC(s0);
    M8_HALF(pX0, pB1, paA, paB, pA1, s0, (void)0);
    M8_PIN(pB1); M8_LDV(s1);
    M8_E4(pB1, 0, paB[4]); M8_E4(pB1, 4, paB[5]); M8_E4(pB1, 8, paB[6]); M8_E4(pB1, 12, paB[7]);
    o[0] = M8_MFMA(paB, f0, o[0]); o[1] = M8_MFMA(paB, f1, o[1]); o[2] = M8_MFMA(paB, ones8, o[2]); }
#undef M8_SB
#undef M8_PIN
#undef M8_LDK
#undef M8_LDV
#undef M8_E4
#undef M8_EX
#undef M8_PK
#undef M8_PIN2
#undef M8_PIN4
#undef M8_PIN6
#undef M8_MX8
#undef M8_TAIL
#undef M8_MXFIN
#undef M8_HALF
  float rli[16];
#pragma unroll
  for (int r = 0; r < 16; ++r) rli[r] = __builtin_amdgcn_rcpf(o[2][r]);
  const int tid_e = opaque_tid(wv), r32e = tid_e & 31, hie = (tid_e >> 5) & 1;
  unsigned char* Ow = O + (size_t)(qrow0 + (tid_e >> 6) * 32) * 1024 + h * 64;
#pragma unroll
  for (int r = 0; r < 16; ++r) { const int orow = crow(r, hie);
#pragma unroll
    for (int d0 = 0; d0 < 2; ++d0) Ow[(size_t)orow * 1024 + d0 * 32 + r32e] = (unsigned char)__builtin_amdgcn_cvt_pk_fp8_f32(o[d0][r] * rli[r], 0.f, 0, false); }
  __syncthreads();
#undef M8_TOK
#undef M8_SLOAD
#undef M8_SLOADX
#undef M8_SWRITEX
#undef M8_SWRITE
#undef M8_RESC
#undef M8_INC
}

#define NA_KSWZ(row, colB) ((row) * 128 + ((colB) ^ ((((row) >> 1) & 7) << 4)))
constexpr int NA_K_OFF = 0, NA_V_OFF = 32768, NA_SLOT = 65536, NA_RPB_OFF = 2 * NA_SLOT, NA_RPB_STRIDE = 576, NA_RPB_PAD = 48, NA_WS_OFF = NA_RPB_OFF + 4 * NA_RPB_STRIDE * 4, NA_LDS = NA_WS_OFF + 8 * 64 * 4;
__device__ __forceinline__ void na_qkt(f32x16& p0, f32x16& p1, const char* Ks, const bf16x8* qr, const f32x16& negm, int r32, int hi) {
#pragma unroll
  for (int d0 = 0; d0 < 4; ++d0) { const int cb = (d0 * 16 + hi * 8) * 2;
    const bf16x8 b0 = *reinterpret_cast<const bf16x8*>(Ks + NA_KSWZ(r32, cb));
    const bf16x8 b1 = *reinterpret_cast<const bf16x8*>(Ks + NA_KSWZ(32 + r32, cb));
    if (d0 == 0) { p0 = __builtin_amdgcn_mfma_f32_32x32x16_bf16(b0, qr[0], negm, 0, 0, 0); p1 = __builtin_amdgcn_mfma_f32_32x32x16_bf16(b1, qr[0], negm, 0, 0, 0); }
    else { p0 = __builtin_amdgcn_mfma_f32_32x32x16_bf16(b0, qr[d0], p0, 0, 0, 0); p1 = __builtin_amdgcn_mfma_f32_32x32x16_bf16(b1, qr[d0], p1, 0, 0, 0); } }
}
__device__ __forceinline__ void na_partialSM(f32x16& p0, f32x16& p1, f32x16& negm, float& alpha, bool first) {
  float pmax = p0[0];
#pragma unroll
  for (int r = 1; r < 16; ++r) pmax = fmaxf(pmax, p0[r]);
#pragma unroll
  for (int r = 0; r < 16; ++r) pmax = fmaxf(pmax, p1[r]);
  { auto rr = __builtin_amdgcn_permlane32_swap(__float_as_uint(pmax), __float_as_uint(pmax), false, false); pmax = fmaxf(__uint_as_float(rr[0]), __uint_as_float(rr[1])); }
  alpha = 1.f;
  if (__builtin_expect(first || !__all(pmax <= THR), 0)) { const float dl = first ? pmax : fmaxf(pmax, 0.f); alpha = first ? 1.f : __builtin_amdgcn_exp2f(-dl);
#pragma unroll
    for (int r = 0; r < 16; ++r) { p0[r] -= dl; p1[r] -= dl; negm[r] -= dl; } }
#pragma unroll
  for (int r = 0; r < 16; ++r) p0[r] = __builtin_amdgcn_exp2f(p0[r]);
}
__device__ __forceinline__ void na_unit(const bf16* __restrict__ Q, const bf16* __restrict__ K, const bf16* __restrict__ V, bf16* __restrict__ O, const float* __restrict__ rpb,
                                        int b, int r, int hg, int is_ctx, char* lds, const int wv) {
  const int tid = opaque_tid(wv), wid = tid >> 6, lane = tid & 63, r32 = lane & 31, hi = lane >> 5;
  const int hh = wid >> 1, half = wid & 1, h = hg * 4 + hh;
  char* Kw = lds + NA_K_OFF + hh * 8192; char* Vw = lds + NA_V_OFF + hh * 8192;
  const float* rpbw = (const float*)(lds + NA_RPB_OFF) + hh * NA_RPB_STRIDE + NA_RPB_PAD;
  float* ws = (float*)(lds + NA_WS_OFF) + wid * 64; float* li_l = ws; float* al_l = ws + 32;
  const size_t lat0 = (size_t)b * 8192, ctx0 = (size_t)65536 + (size_t)b * 256;
  const size_t qtok0 = is_ctx ? ctx0 + (size_t)r * 64 + half * 32 : lat0 + (size_t)r * 64 + half * 32;
  int wstart = r - 4; wstart = wstart < 0 ? 0 : (wstart > 120 ? 120 : wstart);
  const int t0 = is_ctx ? 8 : 0;
  for (int i = tid; i < 4 * NA_RPB_STRIDE; i += 512) { const int hq = i / NA_RPB_STRIDE, w = i % NA_RPB_STRIDE - NA_RPB_PAD; ((float*)(lds + NA_RPB_OFF))[i] = (w >= 0 && w < 465) ? rpb[(size_t)(hg * 4 + hq) * 465 + w] * 1.4426950408889634f : 0.f; }
  float l_reg = 0; f32x16 o[2] = {}; f32x16 negm = {}; bf16x8 qr[4];
  const bf16* Qw = Q + (qtok0 + r32) * 1024 + h * 64 + hi * 8;
#pragma unroll
  for (int d0 = 0; d0 < 4; ++d0) qr[d0] = *reinterpret_cast<const bf16x8*>(Qw + d0 * 16);
  const int srow = tid >> 5, within = tid & 31, shh = within >> 3, sch = within & 7;
  bf16x8 kreg[4], vreg[4];
  const unsigned lat0u = (unsigned)b * 8192u, ctx0u = 65536u + (unsigned)b * 256u;
  const unsigned sloff = (unsigned)((srow * 1024 + hg * 256 + within * 8) * 2);
#define NA_TOK(t) ((t) < 8 ? lat0u + (unsigned)(wstart + (t)) * 64u : ctx0u + (unsigned)((t) - 8) * 64u)
#define NA_SLOAD(t) do { const unsigned tk = NA_TOK(t); _Pragma("unroll") for (int j = 0; j < 4; ++j) { const size_t gb = (size_t)(tk + 16u * j) * 2048; \
    kreg[j] = *reinterpret_cast<const bf16x8*>((const char*)K + gb + sloff); vreg[j] = *reinterpret_cast<const bf16x8*>((const char*)V + gb + sloff); } } while (0)
#define NA_SWRITE(slot) do { _Pragma("unroll") for (int j = 0; j < 4; ++j) { const int row = srow + 16 * j; *(bf16x8*)(lds + (slot) * NA_SLOT + NA_K_OFF + shh * 8192 + NA_KSWZ(row, sch * 16)) = kreg[j]; \
    *(bf16x8*)(lds + (slot) * NA_SLOT + NA_V_OFF + shh * 8192 + v_st(row, sch * 8)) = vreg[j]; } } while (0)
  const int vb = (int)(uintptr_t)Vw + v_rd_base(lane);
  const int qc = half * 32 + r32; int wcol = qc - 8; wcol = wcol < 0 ? 0 : (wcol > 48 ? 48 : wcol);
  typedef const __attribute__((address_space(3))) float* lds_cfp; lds_cfp rpbl = (lds_cfp)(rpbw + (15 - qc + 4 * hi)); asm volatile("" : "+v"(rpbl));
  float mk0[16], mk1[16];
#pragma unroll
  for (int rg = 0; rg < 16; ++rg) { const int j0 = crow(rg, hi); mk0[rg] = ((unsigned)(j0 - wcol) < 16u) ? 0.f : -INFINITY; mk1[rg] = ((unsigned)(j0 + 32 - wcol) < 16u) ? 0.f : -INFINITY; }
  NA_SLOAD(t0); NA_SWRITE(0); if (t0 + 1 < 12) NA_SLOAD(t0 + 1);
  int cur = 0;
  for (int t = t0; t < 12; ++t) {
    __syncthreads();
    if (t + 1 < 12) { NA_SWRITE(cur ^ 1); if (t + 2 < 12) NA_SLOAD(t + 2); }
    f32x16 p0, p1; float alpha; bf16x8 pa0, pa1, pa2, pa3;
    na_qkt(p0, p1, Kw + cur * NA_SLOT, qr, negm, r32, hi);
    if (t < 8) {
      lds_cfp rb = rpbl + (wstart + t - r + 7) * 31;
#pragma unroll
      for (int rg = 0; rg < 16; ++rg) { const int jc = (rg & 3) + 8 * (rg >> 2);
        p0[rg] = (p0[rg] + mk0[rg]) + rb[jc]; p1[rg] = (p1[rg] + mk1[rg]) + rb[jc + 32]; }
    }
    na_partialSM(p0, p1, negm, alpha, t == t0);
    finishSM(p0, p1, alpha, l_reg, pa0, pa1, pa2, pa3);
    if (__any(alpha < 1.f)) { if (hi == 0) al_l[r32] = alpha; asm volatile("s_waitcnt lgkmcnt(0)" ::: "memory");
#pragma unroll
      for (int d = 0; d < 2; ++d)
#pragma unroll
        for (int rg = 0; rg < 16; ++rg) o[d][rg] *= al_l[crow(rg, hi)]; }
    ATT_SBAR();
    pv2(o, vb + cur * NA_SLOT, pa0, pa1, pa2, pa3);
    cur ^= 1;
  }
  if (hi == 0) li_l[r32] = l_reg; asm volatile("s_waitcnt lgkmcnt(0)" ::: "memory");
  float rli[16];
#pragma unroll
  for (int rg = 0; rg < 16; ++rg) rli[rg] = __builtin_amdgcn_rcpf(li_l[crow(rg, hi)]);
  bf16* Ow = O + qtok0 * 1024 + h * 64;
#pragma unroll
  for (int rg = 0; rg < 16; ++rg) { const int orow = crow(rg, hi);
#pragma unroll
    for (int d0 = 0; d0 < 2; ++d0) Ow[(size_t)orow * 1024 + d0 * 32 + r32] = __float2bfloat16(o[d0][rg] * rli[rg]); }
  __syncthreads();
#undef NA_TOK
#undef NA_SLOAD
#undef NA_SWRITE
}
#undef ATT_SBAR
}
constexpr int NWAVES = 8;
#ifndef MK_PER_PHASE
#define MK_PER_PHASE 0
#endif
constexpr int DM = 1024, NB = 8, SEQ = 8192, CTXL = 256, TL = NB * SEQ, TC = NB * CTXL, T0 = TL + TC;
constexpr int NEXP = 32, TOPK = 4, DFF = 1024;
constexpr float NORM_EPS = 1e-6f;
constexpr float LOG2E = 1.4426950408889634f;
constexpr float NA_QSCALE = 0.125f * LOG2E;
constexpr float MLA_QSCALE = 0.10206207261596575f * LOG2E;
constexpr int MAX_BLOCKS = 1088;
constexpr size_t MiB = 1u << 20;
constexpr size_t WS_CTL = 0, CTL_ZERO_BYTES = 1 * MiB;
constexpr size_t WS_MOD = 1 * MiB;
constexpr size_t WS_ROPE = 2 * MiB;
constexpr size_t WS_WR = 3 * MiB;
constexpr size_t WS_WQKV = 4 * MiB;
constexpr size_t WS_WO0 = 10 * MiB;
constexpr size_t WS_WA = 12 * MiB;
constexpr size_t WS_WQB = 13 * MiB;
constexpr size_t WS_WKVB = 14 * MiB;
constexpr size_t WS_WO1 = 15 * MiB;
constexpr size_t WS_TKE = 17 * MiB, WS_TKG = 19 * MiB, WS_TKS = 21 * MiB;
constexpr size_t WS_W1 = 24 * MiB;
constexpr size_t WS_W2 = 280 * MiB;
constexpr size_t WS_XN = 408 * MiB;
constexpr size_t WS_H = 542 * MiB;
constexpr size_t WS_RA = 806 * MiB;
constexpr size_t WS_RB = 1350 * MiB;
constexpr size_t WS_END = 1894 * MiB;
constexpr size_t RA_Q = 0, RA_K = 132 * MiB, RA_V = 264 * MiB, RA_Q1 = 0, RA_KN = 192 * MiB, RA_V1 = 324 * MiB;
constexpr size_t RB_O = 0, RB_WAOUT = 0, RB_QN = 132 * MiB, RB_KVN = 164 * MiB, RB_KR = 181 * MiB, RB_O1 = 186 * MiB;
static_assert((size_t)T0 * 1024 * 2 == 132 * MiB && (size_t)MAX_BLOCKS * 256 * 1024 * 2 == 544 * MiB, "region sizes");
constexpr int CW_CNT0 = 64, CW_CNT1 = 128;
constexpr int CW_BAR = 4096;
constexpr int RING_OFF = 0, RING_BYTES = 131072;
constexpr int LDSCTL_OFF = 154624, MISC_OFF = LDSCTL_OFF + 320;
constexpr int LDS_BYTES = 155648;

#define GAS __attribute__((address_space(1)))
#define LAS __attribute__((address_space(3)))
typedef unsigned short bf16;
typedef unsigned v4u __attribute__((ext_vector_type(4)));
typedef unsigned v2u __attribute__((ext_vector_type(2)));
typedef float f32x4 __attribute__((ext_vector_type(4)));
#define LDS_WAIT() asm volatile("s_waitcnt lgkmcnt(0)" ::: "memory")
__device__ __forceinline__ unsigned f2bf(float f) { unsigned u = __builtin_bit_cast(unsigned, f); return (u + 0x7fffu + ((u >> 16) & 1u)) >> 16; }
__device__ __forceinline__ unsigned pk2(float lo, float hi) { return f2bf(lo) | (f2bf(hi) << 16); }
__device__ __forceinline__ unsigned pk_fp8x4(float a, float b, float c, float d) { int w = __builtin_amdgcn_cvt_pk_fp8_f32(a, b, 0, false); w = __builtin_amdgcn_cvt_pk_fp8_f32(c, d, w, true); return (unsigned)w; }
constexpr float W8_SCALE = 32.0f;
__device__ __forceinline__ float bflo(unsigned w) { return __builtin_bit_cast(float, w << 16); }
__device__ __forceinline__ float bfhi(unsigned w) { return __builtin_bit_cast(float, w & 0xffff0000u); }
__device__ __forceinline__ float wave_sum(float v) {
#pragma unroll
    for (int o = 1; o < 64; o <<= 1) v += __shfl_xor(v, o);
    return v;
}
#define XB_TMO      128
#define XB_XCNT(j)  (256  + 64 * (j))
#define XB_XSUB(j)  (1280 + 64 * (j))
#define XB_XGEN(j)  (2304 + 64 * (j))
#define XB_TOP      3328
#define XB_TOPGEN   3392
#define XCD_BAR_WORDS 3456
#define XB_SPIN_CAP (1u << 18)

__device__ __forceinline__ unsigned xb_ld(unsigned* p)              { return __hip_atomic_load(p, __ATOMIC_RELAXED, __HIP_MEMORY_SCOPE_AGENT); }
__device__ __forceinline__ unsigned xb_add(unsigned* p, unsigned v) { return __hip_atomic_fetch_add(p, v, __ATOMIC_RELAXED, __HIP_MEMORY_SCOPE_AGENT); }
__device__ __forceinline__ unsigned xb_xcc_id() { return (unsigned)__builtin_amdgcn_s_getreg((3 << 11) | 20) & 0xFu; }
#define XB_SPIN(cond, bar) do { unsigned _sp = 0; while (cond) { __builtin_amdgcn_s_sleep(1); \
    if ((++_sp & 255u) == 0u) { if (xb_ld(&(bar)[XB_TMO])) break; if (_sp > XB_SPIN_CAP) { atomicAdd(&(bar)[XB_TMO], 1u); break; } } } } while (0)

struct XcdBarrier {
    unsigned* bar; unsigned x;
    volatile LAS unsigned* st;
};

__device__ __forceinline__ XcdBarrier xcd_barrier_post(unsigned* bar, volatile LAS unsigned* st) {
    XcdBarrier b; b.bar = bar; b.x = xb_xcc_id(); b.st = st;
    if (threadIdx.x == 0) (void)xb_add(&bar[XB_XCNT(b.x)], 1u);
    return b;
}
__device__ __forceinline__ void xcd_barrier_complete(unsigned* bar, unsigned x, unsigned& nloc, unsigned& nx) {
    const unsigned G = gridDim.x * gridDim.y * gridDim.z;
    unsigned sum, cnt, mine, sp = 0u;
    for (;;) {
        sum = 0u; cnt = 0u; mine = 0u;
#pragma unroll
        for (unsigned j = 0; j < 16; ++j) { const unsigned c = xb_ld(&bar[XB_XCNT(j)]); sum += c; cnt += (c > 0u) ? 1u : 0u; mine = (j == x) ? c : mine; }
        if (sum == G) break;
        __builtin_amdgcn_s_sleep(1);
        if ((++sp & 255u) == 0u) { if (xb_ld(&bar[XB_TMO])) break; if (sp > XB_SPIN_CAP) { atomicAdd(&bar[XB_TMO], 1u); break; } }
    }
    nloc = mine > 0u ? mine : 1u; nx = cnt > 0u ? cnt : 1u;
}

__device__ __forceinline__ void xcd_barrier(const XcdBarrier& b) {
    asm volatile("s_waitcnt vmcnt(0)" ::: "memory");
    __syncthreads();
    if (threadIdx.x == 0) {
        unsigned* bar = b.bar;
        __builtin_amdgcn_s_waitcnt(0);
        unsigned nloc = b.st[0], nx = b.st[1];
        if (nloc == 0u) { xcd_barrier_complete(bar, b.x, nloc, nx); b.st[0] = nloc; b.st[1] = nx; }
        const unsigned old = xb_add(&bar[XB_XSUB(b.x)], 1u);
        const unsigned gen = old / nloc;
        if (old + 1u == (gen + 1u) * nloc) {
            __builtin_amdgcn_fence(__ATOMIC_RELEASE, "agent");
            asm volatile("s_waitcnt vmcnt(0)" ::: "memory");
            const unsigned og = xb_add(&bar[XB_TOP], 1u);
            const unsigned tg = og / nx;
            if (og + 1u == (tg + 1u) * nx) xb_add(&bar[XB_TOPGEN], 1u);
            else XB_SPIN(xb_ld(&bar[XB_TOPGEN]) == tg, bar);
            __builtin_amdgcn_fence(__ATOMIC_ACQUIRE, "agent");
            xb_add(&bar[XB_XGEN(b.x)], 1u);
            asm volatile("s_waitcnt vmcnt(0)" ::: "memory");
        } else {
            XB_SPIN(xb_ld(&bar[XB_XGEN(b.x)]) == gen, bar);
            __builtin_amdgcn_fence(__ATOMIC_ACQUIRE, "agent");
            asm volatile("s_waitcnt vmcnt(0)" ::: "memory");
        }
    }
    __syncthreads();
}
#ifndef MK_CHECK
#define MK_CHECK 0
#endif
#if MK_CHECK
namespace chk {
constexpr int CW_CHK = 512;
__device__ __forceinline__ float bf2f(bf16 v) { return __builtin_bit_cast(float, (unsigned)v << 16); }
__device__ __forceinline__ float f8f(unsigned char v) { const unsigned ex = (v >> 3) & 15u, mn = v & 7u; const float m = ex ? __builtin_bit_cast(float, ((ex + 120u) << 23) | (mn << 20)) : (float)mn * 0.001953125f; return (v & 128) ? -m : m; }
__device__ __forceinline__ float wmax(float v) {
#pragma unroll
    for (int o = 1; o < 64; o <<= 1) v = fmaxf(v, __shfl_xor(v, o));
    return v;
}
__device__ __forceinline__ void fail(unsigned* ctl, int i) { __hip_atomic_fetch_add(ctl + CW_CHK + i, 1u, __ATOMIC_RELAXED, __HIP_MEMORY_SCOPE_AGENT); }
__device__ __forceinline__ int clampi(int v, int lo, int hi) { return v < lo ? lo : (v > hi ? hi : v); }
__device__ __forceinline__ bool na_query(const bf16* Q, const bf16* K, const bf16* V, const bf16* O, const float* rpb, int b, int r, int qc, int h, int is_ctx, int lane, LAS float* qs) {
    const size_t qtok = is_ctx ? (size_t)65536 + b * 256 + r * 64 + qc : (size_t)b * 8192 + r * 64 + qc;
    qs[lane] = bf2f(Q[qtok * 1024 + h * 64 + lane]); LDS_WAIT();
    const int n = qc / 16, band_start = clampi(n * 16 - 8, 0, 32), win_start = clampi(qc - 8, 0, 48), ws = clampi(r - 4, 0, 120);
    float s[8]; size_t kt[8];
#pragma unroll
    for (int kk = 0; kk < 8; ++kk) {
        const int idx = lane + 64 * (kk & 3); bool ok; float bias = 0.f;
        if (kk < 4) { const int i = idx / 32, j = idx % 32, kc = band_start + j; kt[kk] = (size_t)b * 8192 + (ws + i) * 64 + kc; ok = !is_ctx && kc >= win_start && kc < win_start + 16;
            bias = rpb[(size_t)h * 465 + (ws + i - r + 7) * 31 + clampi(kc - qc + 15, 0, 30)]; }
        else { kt[kk] = (size_t)65536 + b * 256 + idx; ok = true; }
        float d = 0.f;
        for (int c = 0; c < 64; ++c) d += qs[c] * bf2f(K[kt[kk] * 1024 + h * 64 + c]);
        s[kk] = ok ? d * (1.0f / LOG2E) + bias : -1e30f;
    }
    float m = s[0];
#pragma unroll
    for (int kk = 1; kk < 8; ++kk) m = fmaxf(m, s[kk]);
    m = wmax(m); float l = 0.f;
#pragma unroll
    for (int kk = 0; kk < 8; ++kk) { s[kk] = __expf(s[kk] - m); l += s[kk]; }
    l = wave_sum(l);
    float err = 0.f, sc = 0.f;
    for (int d = 0; d < 64; ++d) { float a = 0.f;
#pragma unroll
        for (int kk = 0; kk < 8; ++kk) a += s[kk] * bf2f(V[kt[kk] * 1024 + h * 64 + d]);
        a = wave_sum(a) / l; const float f = bf2f(O[qtok * 1024 + h * 64 + d]); err = fmaxf(err, fabsf(a - f)); sc = fmaxf(sc, fabsf(a)); }
    return !(err <= 0.03f * sc + 2e-3f);
}
__device__ __forceinline__ bool mla_query(const bf16* Q, const unsigned char* KN, const unsigned char* KRp, const unsigned char* V, const unsigned char* O, int b, int sq, int h, int lane, LAS float* qs, int mode = 0) {
    const size_t qtok = (size_t)b * 8192 + sq;
    for (int d = lane; d < 96; d += 64) qs[d] = bf2f(Q[qtok * 1536 + h * 96 + d]);
    LDS_WAIT();
    if (lane < 16 && mode != 1) { const int p = lane; const float pos = p < 8 ? (float)(sq / 64) : (float)(sq % 64); const float inv = powf(10000.0f, -(float)(2 * (p & 7)) / 16.0f); const float ang = pos * inv;
        const float cs = cosf(ang), sn = mode == 2 ? -sinf(ang) : sinf(ang); const float x0 = qs[64 + 2 * p], x1 = qs[65 + 2 * p]; qs[64 + 2 * p] = x0 * cs - x1 * sn; qs[65 + 2 * p] = x0 * sn + x1 * cs; }
    LDS_WAIT();
    float m = -1e30f, l = 0.f, err = 0.f, sc = 0.f;
    for (int pass = 0; pass < 3; ++pass) {
        float o[32];
#pragma unroll
        for (int d = 0; d < 32; ++d) o[d] = 0.f;
        float lp = 0.f;
        for (int kk = lane; kk < 8448; kk += 64) { const size_t kt = kk < 8192 ? (size_t)b * 8192 + kk : (size_t)65536 + b * 256 + (kk - 8192);
            float d = 0.f;
            for (int c = 0; c < 64; ++c) d += qs[c] * f8f(KN[kt * 1024 + h * 64 + c]);
            if (mode != 3) for (int c = 0; c < 32; ++c) d += qs[64 + c] * f8f(KRp[kt * 32 + c]);
            d *= (1.0f / LOG2E);
            if (pass == 0) m = fmaxf(m, d);
            else { const float p = __expf(d - m); lp += p;
                { const int key = kk & 63; const size_t vb_ = ((size_t)((b * 16 + h) * 132 + (kk >> 6))) * 4096 + 32 * ((key >> 2) & 1) + 16 * (key >> 5) + 4 * ((key >> 3) & 3) + (key & 3);
#pragma unroll
                for (int c = 0; c < 32; ++c) o[c] += p * f8f(V[vb_ + ((pass - 1) * 32 + c) * 64]); } } }
        if (pass == 0) m = wmax(m);
        else { l = wave_sum(lp);
            for (int d = 0; d < 32; ++d) { float od = 0.f;
#pragma unroll
                for (int c = 0; c < 32; ++c) od = (c == d) ? o[c] : od;
                const float a = wave_sum(od) / l; const float f = f8f(O[qtok * 1024 + h * 64 + (pass - 1) * 32 + d]); err = fmaxf(err, fabsf(a - f)); sc = fmaxf(sc, fabsf(a)); } }
    }
    return !(err <= 0.10f * sc + 1e-4f);
}
template <class GetA, class GetOut> __device__ __forceinline__ bool gemm_row(GetA geta, int K, const float* W, int N, int ncols, float scale, GetOut get, int lane, float tol = 0.02f) {
    float err = 0.f, sc = 0.f;
    for (int c0 = 0; c0 < ncols; c0 += 64) { const int col = c0 + lane; float a = 0.f;
        if (col < ncols) { for (int k = 0; k < K; ++k) a += geta(k) * W[(size_t)k * N + col]; a *= scale; err = fmaxf(err, fabsf(a - get(col))); sc = fmaxf(sc, fabsf(a)); } }
    err = wmax(err); sc = wmax(sc);
    return !(err <= tol * sc + 1e-3f);
}
__device__ __forceinline__ bool moe_token(const bf16* XNp, const float* w_r, const float* b_r, const float* w1, const float* b1, const float* w2, const float* b2,
                                          const int* tke, const float* tkg, const int* tks, const unsigned char* ys, int t, int tid, LAS float* sm) {
    LAS float* fl = sm; LAS float* lg = sm + 1024; LAS float* hb = sm + 1088; LAS float* ab = sm + 1088 + 2048; LAS int* bad = (LAS int*)(sm + 1088 + 3072);
    for (int k = tid; k < 1024; k += 512) fl[k] = bf2f(XNp[(size_t)t * 1024 + k]);
    if (tid == 0) bad[0] = 0;
    __syncthreads();
    if (tid < 32) { float a = b_r[tid]; for (int k = 0; k < 1024; ++k) a += fl[k] * w_r[k * 32 + tid]; lg[tid] = a; }
    __syncthreads();
    LAS float* lv = sm + 1088 + 3072 + 64; LAS int* tel = (LAS int*)(sm + 1088 + 3072 + 96); LAS float* tgl = sm + 1088 + 3072 + 100; LAS float* nvl = sm + 1088 + 3072 + 104; LAS float* exl = sm + 1088 + 3072 + 108;
    if (tid < 4) { tel[tid] = tke[(size_t)t * 4 + tid]; tgl[tid] = tkg[(size_t)t * 4 + tid]; }
    __syncthreads();
    if (tid == 0) {
        for (int e = 0; e < 32; ++e) lv[e] = lg[e];
        for (int k = 0; k < 4; ++k) { int bi = 0; for (int e = 1; e < 32; ++e) if (lv[e] > lv[bi]) bi = e; nvl[k] = lv[bi]; lv[bi] = -INFINITY; }
        int b = 0;
        for (int k = 0; k < 4; ++k) { const int ek = tel[k]; if (ek < 0 || ek > 31) { b = 1; break; } if (fabsf(lg[ek] - nvl[k]) > 0.03f) b = 1; for (int j = 0; j < k; ++j) if (tel[j] == ek) b = 1; }
        if (!b) { float s = 0.f; for (int k = 0; k < 4; ++k) { exl[k] = __expf(lg[tel[k]] - lg[tel[0]]); s += exl[k]; } for (int k = 0; k < 4; ++k) if (fabsf(exl[k] / s - tgl[k]) > 0.02f) b = 1; }
        bad[0] = b;
    }
    __syncthreads();
    if (bad[0]) return true;
    float y0 = 0.f, y1 = 0.f;
    for (int k = 0; k < 4; ++k) { const int e = tel[k]; const float gk = tgl[k];
        for (int n = tid; n < 2048; n += 512) { float a = b1[(size_t)e * 2048 + n]; const float* wp = w1 + (size_t)e * 1024 * 2048 + n; for (int kk = 0; kk < 1024; ++kk) a += fl[kk] * wp[(size_t)kk * 2048]; hb[n] = a; }
        __syncthreads();
        for (int j = tid; j < 1024; j += 512) { const float hg = fminf(hb[2 * j], 7.0f), hl = fminf(fmaxf(hb[2 * j + 1], -7.0f), 7.0f); ab[j] = hg * (1.0f / (1.0f + __expf(-1.702f * hg))) * (hl + 1.0f); }
        __syncthreads();
        { float a0 = b2[(size_t)e * 1024 + tid], a1 = b2[(size_t)e * 1024 + tid + 512]; const float* wp = w2 + (size_t)e * 1024 * 1024;
          for (int j = 0; j < 1024; ++j) { a0 += ab[j] * wp[(size_t)j * 1024 + tid]; a1 += ab[j] * wp[(size_t)j * 1024 + tid + 512]; }
          y0 += gk * a0; y1 += gk * a1; }
        __syncthreads();
    }
    float f0 = 0.f, f1 = 0.f;
    for (int k = 0; k < 4; ++k) { const int sl = tks[(size_t)t * 4 + k]; const float gk = tgl[k]; f0 += gk * f8f(ys[(size_t)sl * 1024 + tid]); f1 += gk * f8f(ys[(size_t)sl * 1024 + tid + 512]); }
    float err = fmaxf(fabsf(y0 - f0), fabsf(y1 - f1)), sc = fmaxf(fabsf(y0), fabsf(y1));
    err = wmax(err); sc = wmax(sc);
    LAS float* red = sm + 1088 + 3072 + 16;
    if ((tid & 63) == 0) { red[tid >> 6] = err; red[8 + (tid >> 6)] = sc; }
    __syncthreads();
    float e2 = 0.f, s2 = 0.f;
    for (int w = 0; w < 8; ++w) { e2 = fmaxf(e2, red[w]); s2 = fmaxf(s2, red[8 + w]); }
    __syncthreads();
    return !(e2 <= 0.20f * s2 + 1e-3f);
}
}
#endif
struct Args { const float* in[24]; float* out; unsigned char* ws; int ph_lo, ph_hi; };
struct Frame {
    LAS unsigned char* lds; volatile LAS unsigned* MISC; unsigned* ctl;
    int vcu, G, wv;
};
typedef const __attribute__((address_space(4))) Args KArgs;
__device__ __forceinline__ KArgs* opaque_kernarg() { KArgs* p = (KArgs*)__builtin_amdgcn_kernarg_segment_ptr(); asm volatile("" : "+s"(p)); return p; }
__device__ __forceinline__ unsigned char* opaque_ws() { return opaque_kernarg()->ws; }
__device__ __forceinline__ const float* opaque_in(int i) { return opaque_kernarg()->in[i]; }
#define PHASE_ARGS() KArgs& args = *opaque_kernarg()
#define PHASE_IDS() const int tid = opaque_tid(F.wv), lane = tid & 63, wave = __builtin_amdgcn_readfirstlane(tid >> 6); const int gw = F.vcu * NWAVES + wave, NGW = F.G * NWAVES; \
    const int gtid = blockIdx.x * (NWAVES * 64) + tid, NGT = F.G * NWAVES * 64; (void)lane; (void)gw; (void)NGW; (void)gtid; (void)NGT
__device__ __forceinline__ void p0_transpose_item(const float* W, int K, int N, bf16* WT, LAS float* scr, int item, int lane) {
    const int nblk = N / 32, kb = item / nblk, nb = item % nblk, k0 = 64 * kb, n0 = 32 * nb;
#pragma unroll 8
    for (int i = 0; i < 32; ++i) { const int kk = 2 * i + (lane >> 5); scr[kk * 33 + (lane & 31)] = W[(size_t)(k0 + kk) * N + n0 + (lane & 31)]; }
    LDS_WAIT(); asm volatile("" ::: "memory");
    const int c = lane & 7;
#pragma unroll
    for (int j = 0; j < 4; ++j) { const int n = (lane >> 3) + 8 * j; const LAS float* s = scr + (8 * c) * 33 + n;
        v4u o; o.x = pk2(s[0 * 33], s[1 * 33]); o.y = pk2(s[2 * 33], s[3 * 33]); o.z = pk2(s[4 * 33], s[5 * 33]); o.w = pk2(s[6 * 33], s[7 * 33]);
        *(GAS v4u*)(WT + (size_t)(n0 + n) * K + k0 + 8 * c) = o; }
    LDS_WAIT(); asm volatile("" ::: "memory");
}
__device__ __forceinline__ void p0_transpose_item_fp8(const float* W, int K, int N, unsigned char* WT8, LAS float* scr, int item, int lane) {
    const int nblk = N / 32, kb = item / nblk, nb = item % nblk, k0 = 64 * kb, n0 = 32 * nb;
    const float* wp = W + (size_t)(k0 + (lane >> 5)) * N + n0 + (lane & 31);
#pragma unroll
    for (int h = 0; h < 2; ++h) { float v[16];
#pragma unroll
        for (int i = 0; i < 16; ++i) v[i] = __builtin_nontemporal_load(wp + (size_t)(2 * (16 * h + i)) * N);
#pragma unroll
        for (int i = 0; i < 16; ++i) scr[(2 * (16 * h + i) + (lane >> 5)) * 33 + (lane & 31)] = v[i] * W8_SCALE; }
    LDS_WAIT(); asm volatile("" ::: "memory");
    const int c = lane & 7;
#pragma unroll
    for (int j = 0; j < 4; ++j) { const int n = (lane >> 3) + 8 * j; const LAS float* s = scr + (8 * c) * 33 + n;
        v2u o; o.x = pk_fp8x4(s[0 * 33], s[1 * 33], s[2 * 33], s[3 * 33]); o.y = pk_fp8x4(s[4 * 33], s[5 * 33], s[6 * 33], s[7 * 33]);
        *(GAS v2u*)(WT8 + (size_t)(n0 + n) * K + k0 + 8 * c) = o; }
    LDS_WAIT(); asm volatile("" ::: "memory");
}
__device__ __forceinline__ void load_row(const float* row, int lane, f32x4 (&v)[4]) {
    const GAS f32x4* xr = (const GAS f32x4*)row + lane;
#pragma unroll
    for (int j = 0; j < 4; ++j) v[j] = __builtin_nontemporal_load(xr + 64 * j);
}
__device__ __forceinline__ float row_rstd(const f32x4 (&v)[4]) {
    float s = 0.f;
#pragma unroll
    for (int j = 0; j < 4; ++j) s += (v[j].x * v[j].x + v[j].y * v[j].y) + (v[j].z * v[j].z + v[j].w * v[j].w);
    return 1.0f / sqrtf(wave_sum(s) * (1.0f / 1024.0f) + NORM_EPS);
}
__device__ __forceinline__ void norm_mod_store(const f32x4 (&v)[4], const float* g, const float* sh, const float* sc, bf16* orow, int lane) {
    const float rstd = row_rstd(v);
    GAS v2u* o8 = (GAS v2u*)orow + lane;
#pragma unroll
    for (int j = 0; j < 4; ++j) { const int col = 4 * lane + 256 * j; const f32x4 gv = *(const f32x4*)(g + col), sv = *(const f32x4*)(sh + col), cv = *(const f32x4*)(sc + col);
        const f32x4 a = (v[j] * rstd * gv) * (cv + 1.0f) + sv; v2u w; w.x = pk2(a.x, a.y); w.y = pk2(a.z, a.w); o8[64 * j] = w; }
}
__device__ __forceinline__ void norm_mod_store_both(const f32x4 (&v)[4], const float* g, const float* sh, const float* sc, bf16* orow, unsigned char* orow8, int lane) {
    const float rstd = row_rstd(v);
    GAS v2u* o8 = (GAS v2u*)orow + lane; GAS unsigned* o4 = (GAS unsigned*)orow8 + lane;
#pragma unroll
    for (int j = 0; j < 4; ++j) { const int col = 4 * lane + 256 * j; const f32x4 gv = *(const f32x4*)(g + col), sv = *(const f32x4*)(sh + col), cv = *(const f32x4*)(sc + col);
        const f32x4 a = (v[j] * rstd * gv) * (cv + 1.0f) + sv; v2u w; w.x = pk2(a.x, a.y); w.y = pk2(a.z, a.w); o8[64 * j] = w; o4[64 * j] = pk_fp8x4(a.x, a.y, a.z, a.w); }
}
__device__ __forceinline__ void norm_mod_store_fp8(const f32x4 (&v)[4], const float* g, const float* sh, const float* sc, unsigned char* orow, int lane) {
    const float rstd = row_rstd(v);
    GAS unsigned* o4 = (GAS unsigned*)orow + lane;
#pragma unroll
    for (int j = 0; j < 4; ++j) { const int col = 4 * lane + 256 * j; const f32x4 gv = *(const f32x4*)(g + col), sv = *(const f32x4*)(sh + col), cv = *(const f32x4*)(sc + col);
        const f32x4 a = (v[j] * rstd * gv) * (cv + 1.0f) + sv; o4[64 * j] = pk_fp8x4(a.x, a.y, a.z, a.w); }
}
__device__ __forceinline__ void acc_fp8_row(f32x4 (&y)[4], const unsigned char* row, float gate, int lane) {
    const GAS int* r4 = (const GAS int*)row + lane;
#pragma unroll
    for (int j = 0; j < 4; ++j) { const int w = r4[64 * j]; y[j].x += gate * __builtin_amdgcn_cvt_f32_fp8(w, 0); y[j].y += gate * __builtin_amdgcn_cvt_f32_fp8(w, 1); y[j].z += gate * __builtin_amdgcn_cvt_f32_fp8(w, 2); y[j].w += gate * __builtin_amdgcn_cvt_f32_fp8(w, 3); }
}
__device__ __forceinline__ void acc_bf16_row(f32x4 (&y)[4], const bf16* row, float gate, int lane) {
    const GAS v2u* r8 = (const GAS v2u*)row + lane;
#pragma unroll
    for (int j = 0; j < 4; ++j) { const v2u w = r8[64 * j]; y[j].x += gate * bflo(w.x); y[j].y += gate * bfhi(w.x); y[j].z += gate * bflo(w.y); y[j].w += gate * bfhi(w.y); }
}


__global__ void __launch_bounds__(NWAVES * 64, 2) fwd_kernel(Args args) {
    extern __shared__ __attribute__((aligned(16))) unsigned char lds[];
    Frame F;
    F.lds = (LAS unsigned char*)lds; F.MISC = (volatile LAS unsigned*)(F.lds + MISC_OFF);
    F.wv = __builtin_amdgcn_readfirstlane((int)(threadIdx.x >> 6));
    F.G = gridDim.x; { const int bx = blockIdx.x; F.vcu = (F.G % 8 == 0) ? (bx % 8) * (F.G / 8) + bx / 8 : bx; }
    F.ctl = (unsigned*)(args.ws + WS_CTL);
    for (int u = threadIdx.x; u < (LDS_BYTES - LDSCTL_OFF) / 4; u += NWAVES * 64) ((LAS unsigned*)(F.lds + LDSCTL_OFF))[u] = 0u;
    __syncthreads();
    XcdBarrier bar; bar.bar = F.ctl + CW_BAR; bar.x = 0; bar.st = nullptr;
    if (!MK_PER_PHASE) bar = xcd_barrier_post(F.ctl + CW_BAR, F.MISC + 8);
    const int lo = args.ph_lo, hi = args.ph_hi;
#ifndef MK_PHASE_MASK
#define MK_PHASE_MASK 0x1ffffffu
#endif
#define IN(k) ((((MK_PHASE_MASK) >> (k)) & 1u) && lo <= (k) && (k) < hi)
#define SEAM(k) do { if (IN(k) && IN((k) + 1)) { if ((k) >= 1 && (k) <= 10) { TAIL_FILL(k, false); } else if ((k) == 11) { TAIL_FILL(k, true); } xcd_barrier(bar); } } while (0)
#ifndef MK_DOUBLE_MASK
#define MK_DOUBLE_MASK 0u
#endif
#define REPS(k) for (int rep_ = 0; rep_ < ((((MK_DOUBLE_MASK) >> (k)) & 1u) ? 2 : 1); ++rep_)
#define REP_SEAM() do { if (rep_ == 1) xcd_barrier(bar); } while (0)
#define in_x       (args.in[0])
#define in_c       (args.in[1])
#define in_ctx     (args.in[2])
#define in_cctx    (args.in[3])
#define ada_w      (args.in[4])
#define ada_b      (args.in[5])
#define norm_mix_g (args.in[6])
#define norm_ffn_g (args.in[7])
#define na_w_qkv   (args.in[8])
#define na_rpb     (args.in[9])
#define na_w_o     (args.in[10])
#define mla_w_a    (args.in[11])
#define mla_qn_g   (args.in[12])
#define mla_w_qb   (args.in[13])
#define mla_kvn_g  (args.in[14])
#define mla_w_kvb  (args.in[15])
#define mla_w_o    (args.in[16])
#define moe_w_r    (args.in[17])
#define moe_b_r    (args.in[18])
#define moe_w1     (args.in[19])
#define moe_b1     (args.in[20])
#define moe_w2     (args.in[21])
#define moe_b2     (args.in[22])
#define final_g    (args.in[23])
#define WSP(T, off) ((T*)(args.ws + (off)))
#define MOD    WSP(float, WS_MOD)
#define ROPE   WSP(float, WS_ROPE)
#define WR_T   WSP(bf16, WS_WR)
#define WQKV_T WSP(bf16, WS_WQKV)
#define WO0_T  WSP(bf16, WS_WO0)
#define WA_8   WSP(unsigned char, WS_WA)
#define WQB_T  WSP(bf16, WS_WQB)
#define WKVB_T WSP(bf16, WS_WKVB)
#define WO1_8  WSP(unsigned char, WS_WO1)
#define W1_8   WSP(unsigned char, WS_W1)
#define W2_8   WSP(unsigned char, WS_W2)
#define TKE    WSP(int, WS_TKE)
#define TKG    WSP(float, WS_TKG)
#define TKS    WSP(int, WS_TKS)
#define XN     WSP(bf16, WS_XN)
#define XN8    WSP(unsigned char, WS_XN)
#define H      WSP(float, WS_H)
#define Q0     WSP(bf16, WS_RA + RA_Q)
#define K0     WSP(bf16, WS_RA + RA_K)
#define V0     WSP(bf16, WS_RA + RA_V)
#define O0     WSP(bf16, WS_RB + RB_O)
#define Q1     WSP(bf16, WS_RA + RA_Q1)
#define KN1    WSP(unsigned char, WS_RA + RA_KN)
#define V1     WSP(unsigned char, WS_RA + RA_V1)
#define WAOUT  WSP(float, WS_RB + RB_WAOUT)
#define QN     WSP(bf16, WS_RB + RB_QN)
#define KVN    WSP(bf16, WS_RB + RB_KVN)
#define KR     WSP(unsigned char, WS_RB + RB_KR)
#define O1_8   WSP(unsigned char, WS_RB + RB_O1)
#define XS8    WSP(unsigned char, WS_RA)
#define XN8G   WSP(unsigned char, WS_RA)
#define S2T    WSP(int, WS_RA + 256 * MiB)
#define YS8    WSP(unsigned char, WS_RA)
#define ACT8   WSP(unsigned char, WS_RB)

    constexpr int I_QKV = 16 * 96, I_O = 16 * 32, I_A = 16 * 13, I_QB = 4 * 48, I_KVB = 2 * 64, I_R = 16, I_W1 = 16 * 64, I_W2 = 16 * 32;
    constexpr int P0_NE = 32 * I_W1 + 32 * I_W2 + I_QKV + I_O + 2 * I_R, P0_ND = 32 * I_W1 + 32 * I_W2 + I_O + I_A + I_QB + I_KVB;
    constexpr int CW_DQ = 176, CW_ARR = 192;
#define P0_DO_ITEM(it_) do { int r = (it_); \
        if (r < 64 * I_W1) { const int mi = r / I_W1; p0_transpose_item_fp8(moe_w1 + (size_t)mi * 1024 * 2048, 1024, 2048, W1_8 + (size_t)mi * 2048 * 1024, scr, r % I_W1, lane); break; } r -= 64 * I_W1; \
        if (r < 64 * I_W2) { const int mi = r / I_W2; p0_transpose_item_fp8(moe_w2 + (size_t)mi * 1024 * 1024, 1024, 1024, W2_8 + (size_t)mi * 1024 * 1024, scr, r % I_W2, lane); break; } r -= 64 * I_W2; \
        if (r < I_QKV) { p0_transpose_item_fp8(na_w_qkv, 1024, 3072, (unsigned char*)WQKV_T, scr, r, lane); break; } r -= I_QKV; \
        if (r < I_O) { p0_transpose_item(na_w_o, 1024, 1024, WO0_T, scr, r, lane); break; } r -= I_O; \
        if (r < I_O) { p0_transpose_item_fp8(mla_w_o, 1024, 1024, WO1_8, scr, r, lane); break; } r -= I_O; \
        if (r < I_A) { p0_transpose_item_fp8(mla_w_a, 1024, 416, WA_8, scr, r, lane); break; } r -= I_A; \
        if (r < I_QB) { p0_transpose_item(mla_w_qb, 256, 1536, WQB_T, scr, r, lane); break; } r -= I_QB; \
        if (r < I_KVB) { p0_transpose_item(mla_w_kvb, 128, 2048, WKVB_T, scr, r, lane); break; } r -= I_KVB; \
        { const int l = r / I_R; p0_transpose_item(moe_w_r + (size_t)l * 1024 * 32, 1024, 32, WR_T + (size_t)l * 256 * 1024, scr, r % I_R, lane); } } while (0)
#define TAIL_FILL(kk, DRAIN) do { PHASE_ARGS(); PHASE_IDS(); __syncthreads(); unsigned* ctl_ = WSP(unsigned, WS_CTL); volatile LAS int* qb_ = (volatile LAS int*)(F.lds + LDSCTL_OFF + 512); \
        if (!(DRAIN) && tid == 0) (void)__hip_atomic_fetch_add(ctl_ + CW_ARR + (kk), 1u, __ATOMIC_RELAXED, __HIP_MEMORY_SCOPE_AGENT); \
        LAS float* scr = (LAS float*)(F.lds + RING_OFF + wave * 16384); \
        for (;;) {                                                                \
            if (tid == 0) { int b_ = -1; \
                if ((DRAIN) || __hip_atomic_load(ctl_ + CW_ARR + (kk), __ATOMIC_RELAXED, __HIP_MEMORY_SCOPE_AGENT) < (unsigned)F.G) b_ = (int)__hip_atomic_fetch_add(ctl_ + CW_DQ, 8u, __ATOMIC_RELAXED, __HIP_MEMORY_SCOPE_AGENT); \
                qb_[0] = b_; } \
            __syncthreads(); const int base_ = __builtin_amdgcn_readfirstlane(qb_[0]); \
            if (base_ < 0 || base_ >= P0_ND) break; \
            const int d_ = base_ + wave; \
            if (d_ < P0_ND) { int it; if (d_ < 32 * I_W1) it = 32 * I_W1 + d_; else if (d_ < 32 * I_W1 + 32 * I_W2) it = 64 * I_W1 + 32 * I_W2 + (d_ - 32 * I_W1); else it = 64 * I_W1 + 64 * I_W2 + I_QKV + I_O + (d_ - 32 * I_W1 - 32 * I_W2); \
                P0_DO_ITEM(it); } \
            __syncthreads(); } \
        __syncthreads(); } while (0)
    if (IN(0)) REPS(0) { REP_SEAM(); PHASE_ARGS(); PHASE_IDS();
        if (blockIdx.x < 192) {
            LAS float* sl = (LAS float*)F.lds; LAS float* red = (LAS float*)(F.lds + 40960);
            for (int i = tid; i < 9 * 1024; i += NWAVES * 64) { const float v = i < 8192 ? in_c[i] : in_cctx[i - 8192]; sl[i] = v / (1.0f + __expf(-v)); }
            __syncthreads();
            const int layer = blockIdx.x / 96, n0 = (blockIdx.x % 96) * 64;
            const float* wp = ada_w + (size_t)layer * 1024 * 6144 + n0 + lane;
            float acc[9];
#pragma unroll
            for (int b = 0; b < 9; ++b) acc[b] = 0.f;
#pragma unroll 8
            for (int kk = 0; kk < 128; ++kk) { const int k = wave * 128 + kk; const float wv = wp[(size_t)k * 6144];
#pragma unroll
                for (int b = 0; b < 9; ++b) acc[b] += sl[b * 1024 + k] * wv; }
#pragma unroll
            for (int b = 0; b < 9; ++b) red[(wave * 9 + b) * 64 + lane] = acc[b];
            __syncthreads();
            for (int i = tid; i < 9 * 64; i += NWAVES * 64) { const int b = i >> 6, col = i & 63; float s = ada_b[layer * 6144 + n0 + col];
#pragma unroll
                for (int w = 0; w < 8; ++w) s += red[(w * 9 + b) * 64 + col];
                MOD[(size_t)(layer * 9 + b) * 6144 + n0 + col] = s; }
            __syncthreads();
        }
        for (int i = gtid; i < 8192 * 16; i += NGT) { const int s = i >> 4, p = i & 15; const int pos = p < 8 ? (s >> 6) : (s & 63); const int j = p & 7;
            const double inv = pow(10000.0, -(double)j / 8.0); const double ang = (double)pos * inv; ROPE[2 * i] = (float)cos(ang); ROPE[2 * i + 1] = (float)sin(ang); }
        { const v4u z = {0u, 0u, 0u, 0u};
          for (int i = gtid; i < 96 * 1024 / 16; i += NGT) *(GAS v4u*)(WA_8 + (size_t)416 * 1024 + (size_t)i * 16) = z;
          for (int i = gtid; i < 2 * 224 * 1024 / 8; i += NGT) { const int l = i / (224 * 128), r = i % (224 * 128); *(GAS v4u*)(WR_T + (size_t)l * 256 * 1024 + (size_t)32 * 1024 + (size_t)r * 8) = z; } }
        LAS float* scr = (LAS float*)(F.lds + RING_OFF + wave * 16384);
        for (int e = gw; e < P0_NE; e += NGW) { int it;
            if (e < 32 * I_W1) it = e; else if (e < 32 * I_W1 + 32 * I_W2) it = 64 * I_W1 + (e - 32 * I_W1);
            else if (e < 32 * I_W1 + 32 * I_W2 + I_QKV + I_O) it = 64 * I_W1 + 64 * I_W2 + (e - 32 * I_W1 - 32 * I_W2);
            else it = 64 * I_W1 + 64 * I_W2 + I_QKV + 2 * I_O + I_A + I_QB + I_KVB + (e - 32 * I_W1 - 32 * I_W2 - I_QKV - I_O);
            P0_DO_ITEM(it); }
    }
    SEAM(0);
    if (IN(1)) REPS(1) { REP_SEAM(); PHASE_ARGS(); PHASE_IDS();
        for (int row = 2 * gw; row < T0; row += 2 * NGW) {
            const int bb = row < TL ? (row >> 13) : 8; const float* src = row < TL ? in_x + (size_t)row * DM : in_ctx + (size_t)(row - TL) * DM;
            f32x4 va[4], vb[4]; load_row(src, lane, va); load_row(src + DM, lane, vb); const float* md = MOD + (size_t)bb * 6144;
            norm_mod_store_fp8(va, norm_mix_g, md, md + 1024, XN8 + (size_t)row * DM, lane); norm_mod_store_fp8(vb, norm_mix_g, md, md + 1024, XN8 + (size_t)(row + 1) * DM, lane); }
    }
    SEAM(1);
    if (IN(2)) REPS(2) { REP_SEAM(); PHASE_ARGS();
        pg8::Gemm g{(const bf16*)XN8, WQKV_T, T0, 3072, 512}; pg8::StaticOrder S; S.init(T0, 3072, F.G, (int)blockIdx.x);
        pg8::EpiQKV E{Q0, (size_t)T0 * 1024, NA_QSCALE / W8_SCALE, 1.0f / W8_SCALE};
        pg8::gemm_phase<pg8::EpiQKV, pg8::StaticOrder, true, true, true>(F.lds + RING_OFF, g, S, E, F.wv);
    }
    SEAM(2);
    if (IN(3)) REPS(3) { REP_SEAM(); PHASE_ARGS();
        for (int u = F.vcu; u < 4096 + 128; u += F.G) {
            if (u < 4096) att::na_unit((const att::bf16*)Q0, (const att::bf16*)K0, (const att::bf16*)V0, (att::bf16*)O0, na_rpb, u >> 9, (u >> 2) & 127, u & 3, 0, (char*)lds, F.wv);
            else { const int uc = u - 4096; att::na_unit((const att::bf16*)Q0, (const att::bf16*)K0, (const att::bf16*)V0, (att::bf16*)O0, na_rpb, uc >> 4, (uc >> 2) & 3, uc & 3, 1, (char*)lds, F.wv); }
        }
    }
    SEAM(3);
#if MK_CHECK
    if (IN(4)) REPS(4) { REP_SEAM(); PHASE_ARGS(); PHASE_IDS();
        LAS float* qs = (LAS float*)F.lds + wave * 128;
        for (int it = 0; it < 4; ++it) { const int sidx = gw + NGW * it; const int b = sidx & 7, h = (sidx >> 3) & 15, rq = (sidx >> 7) & 63, k = rq & 15, j = (rq >> 2) & 15;
            const int r = k < 6 ? k : (k < 10 ? 54 + k : 112 + k), qc = j * 4 + (h & 3);
            if (chk::na_query(Q0, K0, V0, O0, na_rpb, b, r, qc, h, 0, lane, qs) && lane == 0) chk::fail(WSP(unsigned, WS_CTL), 0); }
        { const int sidx = gw; const int b = sidx & 7, h = (sidx >> 3) & 15, l = (((sidx >> 7) & 15) * 16 + h) & 255;
          if (chk::na_query(Q0, K0, V0, O0, na_rpb, b, l >> 6, l & 63, h, 1, lane, qs) && lane == 0) chk::fail(WSP(unsigned, WS_CTL), 1); }
        __syncthreads();
    }
#endif
    if (IN(4)) REPS(4) { REP_SEAM(); PHASE_ARGS();
        pg8::Gemm g{O0, WO0_T, T0, 1024, 1024}; pg8::StaticOrder S; S.init(T0, 1024, F.G, (int)blockIdx.x);
        pg8::EpiGateRes E{in_x, in_ctx, TL, H, MOD + 2048, 1.0f, F.wv};
        pg8::gemm_phase<pg8::EpiGateRes, pg8::StaticOrder, true, true>(F.lds + RING_OFF, g, S, E, F.wv);
    }
    SEAM(4);
#define MOE_BLOCK_PHASES(base, LAYER, TT) do { \
    if (IN((base) + 0)) REPS((base) + 0) { REP_SEAM(); PHASE_ARGS(); PHASE_IDS();    \
        for (int row = 2 * gw; row < (TT); row += 2 * NGW) { const int bb = row < TL ? (row >> 13) : 8; f32x4 va[4], vb[4]; load_row(H + (size_t)row * DM, lane, va); load_row(H + (size_t)(row + 1) * DM, lane, vb); \
            const float* md = (MOD + (size_t)(LAYER) * 9 * 6144) + (size_t)bb * 6144; \
            norm_mod_store_both(va, (norm_ffn_g + (LAYER) * 1024), md + 3072, md + 4096, XN + (size_t)row * DM, XN8G + (size_t)row * DM, lane); norm_mod_store_both(vb, (norm_ffn_g + (LAYER) * 1024), md + 3072, md + 4096, XN + (size_t)(row + 1) * DM, XN8G + (size_t)(row + 1) * DM, lane); } } \
    SEAM((base) + 0); \
    if (IN((base) + 1)) REPS((base) + 1) { REP_SEAM(); PHASE_ARGS();     \
        pg8::Gemm g{XN, (WR_T + (size_t)(LAYER) * 256 * 1024), (TT), 256, 1024}; pg8::RowPanelOrder S{(TT) / 256, F.G, (int)blockIdx.x}; pg8::EpiRouter E{(moe_b_r + (LAYER) * 32), TKE, TKG}; \
        pg8::gemm_phase<pg8::EpiRouter, pg8::RowPanelOrder, true, true>(F.lds + RING_OFF, g, S, E, F.wv); } \
    if (IN((base) + 1) && IN((base) + 2)) __syncthreads();     \
    if (IN((base) + 2)) REPS((base) + 2) { REP_SEAM(); PHASE_ARGS(); PHASE_IDS();    \
        LAS int* hist = (LAS int*)F.lds; LAS int* basel = hist + 32; \
        for (int ch = blockIdx.x; ch < (TT) / 256; ch += F.G) { \
            if (tid < 32) hist[tid] = 0; __syncthreads(); \
            int e4[4] = {0, 0, 0, 0}, lr[4] = {0, 0, 0, 0}; const int t = ch * 256 + tid; \
            if (tid < 256) { const int4 ev = *(const int4*)(TKE + (size_t)t * 4); e4[0] = ev.x; e4[1] = ev.y; e4[2] = ev.z; e4[3] = ev.w; \
                _Pragma("unroll") for (int k = 0; k < 4; ++k) lr[k] = atomicAdd((int*)&hist[e4[k]], 1); } \
            __syncthreads(); \
            if (tid < 32) basel[tid] = (int)__hip_atomic_fetch_add((WSP(unsigned, WS_CTL) + ((LAYER) ? CW_CNT1 : CW_CNT0)) + tid, (unsigned)hist[tid], __ATOMIC_RELAXED, __HIP_MEMORY_SCOPE_AGENT); \
            __syncthreads(); \
            if (tid < 256) *(int4*)(TKS + (size_t)t * 4) = make_int4(basel[e4[0]] + lr[0], basel[e4[1]] + lr[1], basel[e4[2]] + lr[2], basel[e4[3]] + lr[3]); \
            __syncthreads(); } } \
    SEAM((base) + 2); \
    if (IN((base) + 3)) REPS((base) + 3) { REP_SEAM(); PHASE_ARGS(); PHASE_IDS();    \
        LAS int* pst = (LAS int*)F.lds; LAS int* pcn = pst + 40; \
        if (tid == 0) { int s = 0; for (int e = 0; e < 32; ++e) { pst[e] = s; const int c = (int)__hip_atomic_load((WSP(unsigned, WS_CTL) + ((LAYER) ? CW_CNT1 : CW_CNT0)) + e, __ATOMIC_RELAXED, __HIP_MEMORY_SCOPE_AGENT); pcn[e] = c; s += (c + 255) / 256 * 256; } pst[32] = s; } \
        __syncthreads(); \
        for (int i = gtid; i < 32 * 256; i += NGT) { const int e = i >> 8, sl = pst[e] + pcn[e] + (i & 255); if (sl < pst[e + 1]) S2T[sl] = 0; }     \
        for (int i = gtid; i < (TT) * 4; i += NGT) { const int slot = pst[TKE[i]] + TKS[i]; TKS[i] = slot; S2T[slot] = i >> 2; }     \
        __syncthreads(); } \
    SEAM((base) + 3); \
    if (IN((base) + 4) || IN((base) + 5)) { PHASE_ARGS(); PHASE_IDS();    \
        LAS int* blk = (LAS int*)(F.lds + LDSCTL_OFF); \
        if (tid == 0) { int s = 0; for (int e = 0; e < 32; ++e) { blk[e] = s; const int c = (int)__hip_atomic_load((WSP(unsigned, WS_CTL) + ((LAYER) ? CW_CNT1 : CW_CNT0)) + e, __ATOMIC_RELAXED, __HIP_MEMORY_SCOPE_AGENT); s += (c + 255) / 256; } blk[32] = s; } \
        __syncthreads(); } \
    if (IN((base) + 4)) REPS((base) + 4) { REP_SEAM(); PHASE_ARGS();     \
        pg8::Gemm g{(const bf16*)XN8G, (const bf16*)(W1_8 + (size_t)(LAYER) * 32 * 2048 * 1024), MAX_BLOCKS * 256, 2048, 512};     pg8::MoeOrderG S{(const LAS int*)(F.lds + LDSCTL_OFF), 8, F.G, (int)blockIdx.x, S2T}; pg8::EpiSwiglu E{WS_RB, 20, (size_t)(LAYER) * 32 * 2048, F.wv}; \
        pg8::gemm_phase<pg8::EpiSwiglu, pg8::MoeOrderG, true, true, true>(F.lds + RING_OFF, g, S, E, F.wv); } \
    SEAM((base) + 4); \
    if (IN((base) + 5)) REPS((base) + 5) { REP_SEAM(); PHASE_ARGS();     \
        pg8::Gemm g{(const bf16*)ACT8, (const bf16*)(W2_8 + (size_t)(LAYER) * 32 * 1024 * 1024), MAX_BLOCKS * 256, 1024, 512}; pg8::MoeOrder S{(const LAS int*)(F.lds + LDSCTL_OFF), 4, F.G, (int)blockIdx.x}; pg8::EpiExpertOut E{WS_RA, 22, (size_t)(LAYER) * 32 * 1024, F.wv}; \
        pg8::gemm_phase<pg8::EpiExpertOut, pg8::MoeOrder, true, true, true>(F.lds + RING_OFF, g, S, E, F.wv); } \
    SEAM((base) + 5); \
} while (0)

    MOE_BLOCK_PHASES(5, 0, T0);

#if MK_CHECK
    if (IN(11)) REPS(11) { REP_SEAM(); PHASE_ARGS(); PHASE_IDS();
        const int t = blockIdx.x >= 240 && 67584 > TL ? TL + (int)(blockIdx.x - 240) * 128 + 5 : (int)((blockIdx.x * 263u + 7u) % (unsigned)TL);
        if (chk::moe_token(XN, moe_w_r + (size_t)0 * 1024 * 32, moe_b_r + 0 * 32, moe_w1 + (size_t)0 * 32 * 1024 * 2048, moe_b1 + (size_t)0 * 32 * 2048, moe_w2 + (size_t)0 * 32 * 1024 * 1024, moe_b2 + (size_t)0 * 32 * 1024,
                           TKE, TKG, TKS, YS8, t, tid, (LAS float*)F.lds) && tid == 0) chk::fail(WSP(unsigned, WS_CTL), 4);
        __syncthreads();
        xcd_barrier(bar);
    }
#endif
    if (IN(11)) REPS(11) { REP_SEAM(); PHASE_ARGS(); PHASE_IDS();
        for (int row = gw; row < T0; row += NGW) { const int bb = row < TL ? (row >> 13) : 8;
            const int sl = TKS[(size_t)row * 4 + (lane & 3)]; const float gt = TKG[(size_t)row * 4 + (lane & 3)];
            f32x4 v[4]; load_row(H + (size_t)row * DM, lane, v); f32x4 y[4];
#pragma unroll
            for (int j = 0; j < 4; ++j) y[j] = (f32x4){0.f, 0.f, 0.f, 0.f};
#pragma unroll
            for (int k = 0; k < 4; ++k) acc_fp8_row(y, YS8 + (size_t)__builtin_amdgcn_readlane(sl, k) * DM, __builtin_bit_cast(float, __builtin_amdgcn_readlane(__builtin_bit_cast(int, gt), k)), lane);
            const float* g2 = MOD + (size_t)bb * 6144 + 5120; GAS f32x4* hp = (GAS f32x4*)(H + (size_t)row * DM) + lane;
#pragma unroll
            for (int j = 0; j < 4; ++j) { v[j] = v[j] + *(const f32x4*)(g2 + 4 * lane + 256 * j) * y[j]; hp[64 * j] = v[j]; }
            const float* md = MOD + (size_t)(9 + bb) * 6144;
            norm_mod_store_fp8(v, norm_mix_g + 1024, md, md + 1024, XN8 + (size_t)row * DM, lane); }
    }
    SEAM(11);
    if (IN(12)) REPS(12) { REP_SEAM(); PHASE_ARGS();
        pg8::Gemm g{(const bf16*)XN8, (const bf16*)WA_8, T0, 512, 512}; pg8::StaticOrder S; S.init(T0, 512, F.G, (int)blockIdx.x);
        pg8::EpiF32 E{WAOUT, 512, 1.0f / W8_SCALE};
        pg8::gemm_phase<pg8::EpiF32, pg8::StaticOrder, true, true, true>(F.lds + RING_OFF, g, S, E, F.wv);
    }
    SEAM(12);
    if (IN(13)) REPS(13) { REP_SEAM(); PHASE_ARGS(); PHASE_IDS();
        for (int row = gw; row < T0; row += NGW) { const float* wr = WAOUT + (size_t)row * 512;
            const f32x4 q = *(const GAS f32x4*)(wr + 4 * lane); const float k0 = wr[256 + 2 * lane], k1 = wr[257 + 2 * lane];
            const float qs = wave_sum((q.x * q.x + q.y * q.y) + (q.z * q.z + q.w * q.w)), ks = wave_sum(k0 * k0 + k1 * k1);
            if (row < TL) { const float rq = 1.0f / sqrtf(qs * (1.0f / 256.0f) + NORM_EPS); const f32x4 gq = *(const f32x4*)(mla_qn_g + 4 * lane);
                v2u w; w.x = pk2(q.x * rq * gq.x, q.y * rq * gq.y); w.y = pk2(q.z * rq * gq.z, q.w * rq * gq.w); *((GAS v2u*)(QN + (size_t)row * 256) + lane) = w; }
            const float rk = 1.0f / sqrtf(ks * (1.0f / 128.0f) + NORM_EPS);
            *((GAS unsigned*)(KVN + (size_t)row * 128) + lane) = pk2(k0 * rk * mla_kvn_g[2 * lane], k1 * rk * mla_kvn_g[2 * lane + 1]);
            if (lane < 16) { const float r0 = wr[384 + 2 * lane], r1 = wr[385 + 2 * lane]; float o0 = r0, o1 = r1;
                if (row < TL) { const float cs = ROPE[((size_t)(row & 8191) * 16 + lane) * 2], sn = ROPE[((size_t)(row & 8191) * 16 + lane) * 2 + 1]; o0 = r0 * cs - r1 * sn; o1 = r0 * sn + r1 * cs; }
                *((GAS unsigned short*)(KR + (size_t)row * 32) + lane) = (unsigned short)__builtin_amdgcn_cvt_pk_fp8_f32(o0, o1, 0, false); } }
    }
    SEAM(13);
#if MK_CHECK
    if (IN(14)) REPS(14) { REP_SEAM(); PHASE_ARGS(); PHASE_IDS();
        const int row = (int)(((unsigned)gw * 33u + 11u) % (unsigned)T0); const float* wr = WAOUT + (size_t)row * 512; bool bad = false;
        { const float* Wp = mla_w_a; const unsigned char* Ap = XN8 + (size_t)row * 1024; bad |= chk::gemm_row([Ap](int k) { return chk::f8f(Ap[k]); }, 1024, Wp, 416, 416, 1.0f, [wr](int col) { return wr[col]; }, lane, 0.15f); }
        { float qv[4], ss = 0.f;
#pragma unroll
          for (int i = 0; i < 4; ++i) { qv[i] = wr[4 * lane + i]; ss += qv[i] * qv[i]; }
          ss = wave_sum(ss); const float rq = 1.0f / sqrtf(ss / 256.0f + NORM_EPS);
          if (row < TL) {
#pragma unroll
            for (int i = 0; i < 4; ++i) { const float ref = qv[i] * rq * mla_qn_g[4 * lane + i]; if (!(fabsf(ref - chk::bf2f(QN[(size_t)row * 256 + 4 * lane + i])) <= 0.01f * fabsf(ref) + 1e-3f)) bad = true; } }
          const float k0 = wr[256 + 2 * lane], k1 = wr[257 + 2 * lane]; const float ks = wave_sum(k0 * k0 + k1 * k1); const float rk = 1.0f / sqrtf(ks / 128.0f + NORM_EPS);
          const float r0 = k0 * rk * mla_kvn_g[2 * lane], r1 = k1 * rk * mla_kvn_g[2 * lane + 1];
          if (!(fabsf(r0 - chk::bf2f(KVN[(size_t)row * 128 + 2 * lane])) <= 0.01f * fabsf(r0) + 1e-3f) || !(fabsf(r1 - chk::bf2f(KVN[(size_t)row * 128 + 2 * lane + 1])) <= 0.01f * fabsf(r1) + 1e-3f)) bad = true;
          if (lane < 16) { const int p = lane, sq = row & 8191; float x0 = wr[384 + 2 * p], x1 = wr[385 + 2 * p];
              if (row < TL) { const float pos = p < 8 ? (float)(sq / 64) : (float)(sq % 64); const float inv = powf(10000.0f, -(float)(2 * (p & 7)) / 16.0f); const float ang = pos * inv; const float cs = cosf(ang), sn = sinf(ang);
                  const float a0 = x0 * cs - x1 * sn, a1 = x0 * sn + x1 * cs; x0 = a0; x1 = a1; }
              if (!(fabsf(x0 - chk::f8f(KR[(size_t)row * 32 + 2 * p])) <= 0.07f * fabsf(x0) + 4e-3f) || !(fabsf(x1 - chk::f8f(KR[(size_t)row * 32 + 2 * p + 1])) <= 0.07f * fabsf(x1) + 4e-3f)) bad = true; } }
        if (__any(bad) && lane == 0) chk::fail(WSP(unsigned, WS_CTL), 3);
    }
#endif
    if (IN(14)) REPS(14) { REP_SEAM(); PHASE_ARGS();
        { pg8::Gemm g{QN, WQB_T, TL, 1536, 256}; pg8::StaticOrder S; S.init(TL, 1536, F.G, (int)blockIdx.x);
          pg8::EpiScaleBf16 E{Q1, 1536, MLA_QSCALE};
          pg8::gemm_phase<pg8::EpiScaleBf16, pg8::StaticOrder, false, true>(F.lds + RING_OFF, g, S, E, F.wv); }
    }
    SEAM(14);
    if (IN(15)) REPS(15) { REP_SEAM(); PHASE_ARGS();
        { pg8::Gemm g{KVN, WKVB_T, T0, 2048, 128}; pg8::StaticOrder S; S.init(T0, 2048, F.G, (int)blockIdx.x);
          pg8::EpiKV E{KN1, V1, F.wv};
          pg8::gemm_phase<pg8::EpiKV, pg8::StaticOrder, true, true>(F.lds + RING_OFF, g, S, E, F.wv); }
    }
    SEAM(15);
#if MK_CHECK
    if (IN(16)) REPS(16) { REP_SEAM(); PHASE_ARGS(); PHASE_IDS();
        const int row = (int)(((unsigned)gw * 33u + 11u) % (unsigned)T0); bool bad = false;
        if (row < TL) { const bf16* qp = Q1 + (size_t)row * 1536; { const bf16* Ap = QN + (size_t)row * 256; bad |= chk::gemm_row([Ap](int k) { return chk::bf2f(Ap[k]); }, 256, mla_w_qb, 1536, 1536, MLA_QSCALE, [qp](int col) { return chk::bf2f(qp[col]); }, lane); } }
        { const unsigned char* kp = KN1 + (size_t)row * 1024; const unsigned char* vt = V1;
          const bf16* Ap = KVN + (size_t)row * 128; bad |= chk::gemm_row([Ap](int k) { return chk::bf2f(Ap[k]); }, 128, mla_w_kvb, 2048, 2048, 1.0f, [kp, vt, row](int col) { const int hh = col >> 7, jj = col & 127; if (jj < 64) return chk::f8f(kp[hh * 64 + jj]);
              const int bb = row < TL ? (row >> 13) : ((row - TL) >> 8), tile = row < TL ? ((row & 8191) >> 6) : 128 + (((row - TL) & 255) >> 6), key = row & 63;
              return chk::f8f(vt[((size_t)((bb * 16 + hh) * 132 + tile)) * 4096 + (jj - 64) * 64 + 32 * ((key >> 2) & 1) + 16 * (key >> 5) + 4 * ((key >> 3) & 3) + (key & 3)]); }, lane, 0.10f); }
        if (__any(bad) && lane == 0) chk::fail(WSP(unsigned, WS_CTL), 3);
    }
#endif
    if (IN(16)) REPS(16) { REP_SEAM(); PHASE_ARGS();
        att::mla8_zero_pad((char*)lds, F.wv);
        for (int u = F.vcu; u < 4096; u += F.G) { const int qb = u & 31, bh = u >> 5, b = bh >> 4, h = bh & 15;
            att::mla8_unit((const att::bf16*)Q1, KN1, KR, V1, (unsigned char*)O1_8, ROPE, b, h, b * 8192 + qb * 256, (char*)lds, F.wv); }
    }
    SEAM(16);
#if MK_CHECK
    if (IN(17)) REPS(17) { REP_SEAM(); PHASE_ARGS(); PHASE_IDS();
        LAS float* qs = (LAS float*)F.lds + wave * 128;
        const int b = gw & 7, h = (gw >> 3) & 15, k = (gw >> 7) & 15; const int sq = k == 0 ? 0 : (k == 1 ? 63 : (k == 2 ? 64 : (k == 3 ? 8191 : ((k * 547 + h * 37) & 8191))));
        if (chk::mla_query(Q1, KN1, KR, V1, O1_8, b, sq, h, lane, qs) && lane == 0) chk::fail(WSP(unsigned, WS_CTL), 2);
#if MK_CHECK == 2
        if (chk::mla_query(Q1, KN1, KR, V1, O1_8, b, sq, h, lane, qs, 1) && lane == 0) chk::fail(WSP(unsigned, WS_CTL), 0);
        if (chk::mla_query(Q1, KN1, KR, V1, O1_8, b, sq, h, lane, qs, 2) && lane == 0) chk::fail(WSP(unsigned, WS_CTL), 1);
        if (chk::mla_query(Q1, KN1, KR, V1, O1_8, b, sq, h, lane, qs, 3) && lane == 0) chk::fail(WSP(unsigned, WS_CTL), 3);
#endif
        __syncthreads();
    }
#endif
    if (IN(17)) REPS(17) { REP_SEAM(); PHASE_ARGS();
        pg8::Gemm g{(const bf16*)O1_8, (const bf16*)WO1_8, TL, 1024, 512}; pg8::StaticOrder S; S.init(TL, 1024, F.G, (int)blockIdx.x);
        pg8::EpiGateRes E{H, H, 0x7fffffff, H, MOD + (size_t)9 * 6144 + 2048, 1.0f / W8_SCALE, F.wv};
        pg8::gemm_phase<pg8::EpiGateRes, pg8::StaticOrder, true, true, true>(F.lds + RING_OFF, g, S, E, F.wv);
    }
    SEAM(17);
    MOE_BLOCK_PHASES(18, 1, TL);
#if MK_CHECK
    if (IN(24)) REPS(24) { REP_SEAM(); PHASE_ARGS(); PHASE_IDS();
        const int t = blockIdx.x >= 240 && 65536 > TL ? TL + (int)(blockIdx.x - 240) * 128 + 5 : (int)((blockIdx.x * 263u + 7u) % (unsigned)TL);
        if (chk::moe_token(XN, moe_w_r + (size_t)1 * 1024 * 32, moe_b_r + 1 * 32, moe_w1 + (size_t)1 * 32 * 1024 * 2048, moe_b1 + (size_t)1 * 32 * 2048, moe_w2 + (size_t)1 * 32 * 1024 * 1024, moe_b2 + (size_t)1 * 32 * 1024,
                           TKE, TKG, TKS, YS8, t, tid, (LAS float*)F.lds) && tid == 0) chk::fail(WSP(unsigned, WS_CTL), 4);
        __syncthreads();
        xcd_barrier(bar);
    }
#endif
    if (IN(24)) REPS(24) { REP_SEAM(); PHASE_ARGS(); PHASE_IDS();
        for (int row = gw; row < TL; row += NGW) { const int bb = row >> 13;
            const int sl = TKS[(size_t)row * 4 + (lane & 3)]; const float gt = TKG[(size_t)row * 4 + (lane & 3)];
            f32x4 v[4]; load_row(H + (size_t)row * DM, lane, v); f32x4 y[4];
#pragma unroll
            for (int j = 0; j < 4; ++j) y[j] = (f32x4){0.f, 0.f, 0.f, 0.f};
#pragma unroll
            for (int k = 0; k < 4; ++k) acc_fp8_row(y, YS8 + (size_t)__builtin_amdgcn_readlane(sl, k) * DM, __builtin_bit_cast(float, __builtin_amdgcn_readlane(__builtin_bit_cast(int, gt), k)), lane);
            const float* g2 = MOD + (size_t)(9 + bb) * 6144 + 5120;
#pragma unroll
            for (int j = 0; j < 4; ++j) v[j] = v[j] + *(const f32x4*)(g2 + 4 * lane + 256 * j) * y[j];
            const float rstd = row_rstd(v); GAS f32x4* op = (GAS f32x4*)(args.out + (size_t)row * DM) + lane;
#if MK_CHECK
            { const unsigned* cw = WSP(unsigned, WS_CTL) + chk::CW_CHK; int ci = -1;
              if (row < 32768) ci = 0; else if (row < 49152) ci = 1; else if (row < 57344) ci = 2; else if (row < 61440) ci = 3; else if (row < 63488) ci = 4; else if (row < 64512) ci = 5;
              const bool z = ci == 5 || (ci >= 0 && __hip_atomic_load(cw + ci, __ATOMIC_RELAXED, __HIP_MEMORY_SCOPE_AGENT) != 0u);
              if (z) {
#pragma unroll
                for (int j = 0; j < 4; ++j) v[j] = (f32x4){0.f, 0.f, 0.f, 0.f}; } }
#endif
#pragma unroll
            for (int j = 0; j < 4; ++j) __builtin_nontemporal_store(v[j] * rstd * *(const f32x4*)(final_g + 4 * lane + 256 * j), op + 64 * j); }
    }
#undef IN
#undef SEAM
}

constexpr int N_PHASES = 25;
extern "C" void kernel_launch(void* const* d_in, const int* in_sizes, int n_in, void* d_out, int out_size, void* d_ws, size_t ws_size, hipStream_t stream) {
    static int grid = 0;
    if (grid == 0) {
        if (n_in != 24 || in_sizes[0] != TL * DM || out_size != TL * DM || ws_size < WS_END) { fprintf(stderr, "kernel_launch: unexpected shapes: n_in %d in0 %d out %d ws %zu (need >= %zu)\n", n_in, n_in > 0 ? in_sizes[0] : -1, out_size, ws_size, (size_t)WS_END); grid = -1; return; }
        int dev = 0, cus = 0, per_cu = 0;
        if (hipGetDevice(&dev) != hipSuccess || hipDeviceGetAttribute(&cus, hipDeviceAttributeMultiprocessorCount, dev) != hipSuccess) { fprintf(stderr, "kernel_launch: device query failed\n"); grid = -1; return; }
        if (hipFuncSetAttribute((const void*)fwd_kernel, hipFuncAttributeMaxDynamicSharedMemorySize, LDS_BYTES) != hipSuccess) { fprintf(stderr, "kernel_launch: hipFuncSetAttribute failed\n"); grid = -1; return; }
        if (hipOccupancyMaxActiveBlocksPerMultiprocessor(&per_cu, (const void*)fwd_kernel, NWAVES * 64, LDS_BYTES) != hipSuccess || per_cu < 1) { fprintf(stderr, "kernel_launch: occupancy query reports %d workgroups per CU\n", per_cu); }
        (void)hipGetLastError();
        grid = cus;
    }
    if (grid < 0) return;
    if (hipMemsetAsync((char*)d_ws + WS_CTL, 0, CTL_ZERO_BYTES, stream) != hipSuccess) { fprintf(stderr, "kernel_launch: memset failed\n"); return; }
    Args a{};
    for (int i = 0; i < 24; ++i) a.in[i] = (const float*)d_in[i];
    a.out = (float*)d_out; a.ws = (unsigned char*)d_ws;
#if MK_PER_PHASE
    for (int p = 0; p < N_PHASES; ++p) { a.ph_lo = p; a.ph_hi = p + 1; hipLaunchKernelGGL(fwd_kernel, dim3(grid), dim3(NWAVES * 64), LDS_BYTES, stream, a); }
#else
    a.ph_lo = 0; a.ph_hi = N_PHASES; hipLaunchKernelGGL(fwd_kernel, dim3(grid), dim3(NWAVES * 64), LDS_BYTES, stream, a);
#endif
    const hipError_t le = hipPeekAtLastError();
    if (le != hipSuccess) fprintf(stderr, "kernel_launch: launch failed: %s\n", hipGetErrorName(le));
}
```
